# Optimizing an MI355X kernel written in HIP

```python
import math
import jax, jax.numpy as jnp
from jax import lax
import numpy as np

D_MODEL = 2048
BATCH = 2
SEQ = 8192
DEPTH = 4
DEC_BATCH = 32
DEC_SEQ = 64
PAST_LEN = 1024

CHUNK = 64
D_SSM = D_MODEL // 2
D_ATT = D_MODEL // 2
D_INNER = D_SSM + D_ATT
SSM_GROUP = 16
N_GROUPS = D_SSM // SSM_GROUP
STATE_DIM = 64
HEAD_DIM = 128
N_HEADS = D_ATT // HEAD_DIM
Q_BLOCK = 128
D_PROJ = 2 * D_SSM + 4 * D_ATT + N_HEADS
EPS = 1e-6
F_BIAS_INIT = 3.0
DT_MIN = 0.001
DT_MAX = 0.1

kernel_name = "hymba_s5_fox_streaming_encoder"


def _rmsnorm(x, g):
    xf = x.astype(jnp.float32)
    y = xf * lax.rsqrt(jnp.mean(xf * xf, axis=-1, keepdims=True) + EPS)
    return (y * g.astype(jnp.float32)).astype(x.dtype)


def _s5_scan(u, log_dt, a_re, a_im, b_re, b_im, c_re, c_im, d, h0_re, h0_im):
    f32 = jnp.float32
    bsz, L, _ = u.shape
    uf = u.astype(f32).reshape(bsz, L, N_GROUPS, SSM_GROUP)
    dt = jnp.exp(log_dt.astype(f32))[:, None]
    ar = a_re.astype(f32)
    ai = a_im.astype(f32)
    mag = jnp.exp(ar * dt)
    abar_re = mag * jnp.cos(ai * dt)
    abar_im = mag * jnp.sin(ai * dt)
    den = ar * ar + ai * ai
    nr = abar_re - 1.0
    ni = abar_im
    coef_re = (nr * ar + ni * ai) / den
    coef_im = (ni * ar - nr * ai) / den
    bu_re = jnp.einsum('blgc,gpc->blgp', uf, b_re.astype(f32))
    bu_im = jnp.einsum('blgc,gpc->blgp', uf, b_im.astype(f32))
    bb_re = coef_re * bu_re - coef_im * bu_im
    bb_im = coef_re * bu_im + coef_im * bu_re
    if h0_re is not None:
        h0r = h0_re.astype(f32)
        h0i = h0_im.astype(f32)
        bb_re = bb_re.at[:, 0].add(abar_re * h0r - abar_im * h0i)
        bb_im = bb_im.at[:, 0].add(abar_re * h0i + abar_im * h0r)
    a_re_t = jnp.broadcast_to(abar_re, bb_re.shape)
    a_im_t = jnp.broadcast_to(abar_im, bb_im.shape)

    def combine(e1, e2):
        a1r, a1i, b1r, b1i = e1
        a2r, a2i, b2r, b2i = e2
        return (a2r * a1r - a2i * a1i,
                a2r * a1i + a2i * a1r,
                a2r * b1r - a2i * b1i + b2r,
                a2r * b1i + a2i * b1r + b2i)

    _, _, h_re, h_im = lax.associative_scan(combine, (a_re_t, a_im_t, bb_re, bb_im), axis=1)
    y = (jnp.einsum('blgp,gcp->blgc', h_re, c_re.astype(f32))
         - jnp.einsum('blgp,gcp->blgc', h_im, c_im.astype(f32))
         + d.astype(f32) * uf)
    return y.reshape(bsz, L, D_SSM), h_re[:, -1], h_im[:, -1]


def _fox_block(q, cq, qpos, k, v, ck, kpos):
    s = jnp.einsum('bqhd,bkhd->bhqk', q, k).astype(jnp.float32) * (HEAD_DIM ** -0.5)
    s = s + (jnp.transpose(cq, (0, 2, 1))[..., :, None] - jnp.transpose(ck, (0, 2, 1))[..., None, :])
    mask = kpos[None, :] <= qpos[:, None]
    s = jnp.where(mask, s, -jnp.inf)
    p = jax.nn.softmax(s, axis=-1)
    return jnp.einsum('bhqk,bkhd->bqhd', p.astype(v.dtype), v)


def _layer(x, params, past):
    (g, w_in, b_f, qg, kg, log_dt, a_re, a_im, b_re, b_im, c_re, c_im, d,
     w_glu, b_glu, ssm_ng, att_ng, w_out) = params
    bsz, L, _ = x.shape
    h = _rmsnorm(x, g)
    proj = h @ w_in
    splits = [D_SSM, 2 * D_SSM, 2 * D_SSM + D_ATT, 2 * D_SSM + 2 * D_ATT,
              2 * D_SSM + 3 * D_ATT, 2 * D_SSM + 4 * D_ATT]
    u, z_ssm, q, k, v, z_att, f_pre = jnp.split(proj, splits, axis=-1)

    if past is None:
        h0_re, h0_im = None, None
    else:
        h0_re, h0_im = past[3], past[4]
    y_ssm, hT_re, hT_im = _s5_scan(u, log_dt, a_re, a_im, b_re, b_im, c_re, c_im, d, h0_re, h0_im)
    zs = jax.nn.gelu(y_ssm, approximate=False)
    y_ssm = zs * jax.nn.sigmoid(zs @ w_glu.astype(jnp.float32) + b_glu.astype(jnp.float32))
    y_ssm = y_ssm * jax.nn.silu(z_ssm.astype(jnp.float32))
    y_ssm = _rmsnorm(y_ssm, ssm_ng).astype(x.dtype)

    q = _rmsnorm(q.reshape(bsz, L, N_HEADS, HEAD_DIM), qg)
    k = _rmsnorm(k.reshape(bsz, L, N_HEADS, HEAD_DIM), kg)
    v = v.reshape(bsz, L, N_HEADS, HEAD_DIM)
    logf = jax.nn.log_sigmoid(f_pre.astype(jnp.float32) + b_f.astype(jnp.float32))
    if past is None:
        k_all, v_all, logf_all = k, v, logf
        offset = 0
    else:
        k_past, v_past, logf_past = past[0], past[1], past[2]
        k_all = jnp.concatenate([k_past, k.astype(k_past.dtype)], axis=1)
        v_all = jnp.concatenate([v_past, v.astype(v_past.dtype)], axis=1)
        logf_all = jnp.concatenate([logf_past.astype(jnp.float32), logf], axis=1)
        offset = k_past.shape[1]
    c_all = jnp.cumsum(logf_all, axis=1)
    cq = c_all[:, offset:]
    S = k_all.shape[1]
    kpos = jnp.arange(S, dtype=jnp.int32)
    qpos = offset + jnp.arange(L, dtype=jnp.int32)
    q = q.astype(k_all.dtype)
    if L <= Q_BLOCK:
        o = _fox_block(q, cq, qpos, k_all, v_all, c_all, kpos)
    else:
        nblk = L // Q_BLOCK
        qb = jnp.transpose(q.reshape(bsz, nblk, Q_BLOCK, N_HEADS, HEAD_DIM), (1, 0, 2, 3, 4))
        cqb = jnp.transpose(cq.reshape(bsz, nblk, Q_BLOCK, N_HEADS), (1, 0, 2, 3))
        qposb = qpos.reshape(nblk, Q_BLOCK)
        ob = lax.map(lambda a: _fox_block(a[0], a[1], a[2], k_all, v_all, c_all, kpos), (qb, cqb, qposb))
        o = jnp.transpose(ob, (1, 0, 2, 3, 4))
    o = o.reshape(bsz, L, D_ATT).astype(jnp.float32)
    y_att = _rmsnorm(o * jax.nn.silu(z_att.astype(jnp.float32)), att_ng).astype(x.dtype)

    y = jnp.concatenate([y_ssm, y_att], axis=-1)
    x = x + (y @ w_out).astype(x.dtype)
    return x, (k, v, logf, hT_re, hT_im)


def setup_inputs(seed: int = 0) -> dict:
    key = jax.random.key(seed)
    ks = jax.random.split(key, 32)
    f32 = jnp.float32
    nrm = lambda k, shape, scale: jax.random.normal(k, shape, f32) * scale
    x_prompt = nrm(ks[0], (BATCH, SEQ, D_MODEL), 1.0)
    x_sample = nrm(ks[1], (DEC_BATCH, DEC_SEQ, D_MODEL), 1.0)
    cache_k = nrm(ks[2], (DEPTH, DEC_BATCH, PAST_LEN, N_HEADS, HEAD_DIM), 1.0)
    cache_v = nrm(ks[3], (DEPTH, DEC_BATCH, PAST_LEN, N_HEADS, HEAD_DIM), 1.0)
    cache_logf = jax.nn.log_sigmoid(F_BIAS_INIT + nrm(ks[4], (DEPTH, DEC_BATCH, PAST_LEN, N_HEADS), 1.0))
    state_ssm_re = nrm(ks[5], (DEPTH, DEC_BATCH, N_GROUPS, STATE_DIM), 0.1)
    state_ssm_im = nrm(ks[6], (DEPTH, DEC_BATCH, N_GROUPS, STATE_DIM), 0.1)
    norm_gain = 1.0 + nrm(ks[7], (DEPTH, D_MODEL), 0.01)
    w_in = nrm(ks[8], (DEPTH, D_MODEL, D_PROJ), D_MODEL ** -0.5)
    b_f = F_BIAS_INIT + nrm(ks[9], (DEPTH, N_HEADS), 0.1)
    q_norm_gain = 1.0 + nrm(ks[10], (DEPTH, HEAD_DIM), 0.01)
    k_norm_gain = 1.0 + nrm(ks[11], (DEPTH, HEAD_DIM), 0.01)
    ssm_log_dt = jax.random.uniform(ks[12], (DEPTH, N_GROUPS), f32, math.log(DT_MIN), math.log(DT_MAX))
    n_idx = jnp.arange(STATE_DIM, dtype=f32)
    ssm_a_re = -0.5 + nrm(ks[13], (DEPTH, N_GROUPS, STATE_DIM), 0.01)
    ssm_a_im = math.pi * n_idx + nrm(ks[14], (DEPTH, N_GROUPS, STATE_DIM), 0.01)
    ssm_b_re = nrm(ks[15], (DEPTH, N_GROUPS, STATE_DIM, SSM_GROUP), (2 * SSM_GROUP) ** -0.5)
    ssm_b_im = nrm(ks[16], (DEPTH, N_GROUPS, STATE_DIM, SSM_GROUP), (2 * SSM_GROUP) ** -0.5)
    ssm_c_re = nrm(ks[17], (DEPTH, N_GROUPS, SSM_GROUP, STATE_DIM), STATE_DIM ** -0.5)
    ssm_c_im = nrm(ks[18], (DEPTH, N_GROUPS, SSM_GROUP, STATE_DIM), STATE_DIM ** -0.5)
    ssm_d = nrm(ks[19], (DEPTH, N_GROUPS, SSM_GROUP), 1.0)
    w_glu = nrm(ks[20], (DEPTH, D_SSM, D_SSM), D_SSM ** -0.5)
    b_glu = nrm(ks[21], (DEPTH, D_SSM), 0.01)
    ssm_out_norm = 1.0 + nrm(ks[22], (DEPTH, D_SSM), 0.01)
    att_out_norm = 1.0 + nrm(ks[23], (DEPTH, D_ATT), 0.01)
    w_out = nrm(ks[24], (DEPTH, D_INNER, D_MODEL), 0.5 * D_INNER ** -0.5)
    return {"x_prompt": x_prompt, "x_sample": x_sample,
            "cache_k": cache_k, "cache_v": cache_v, "cache_logf": cache_logf,
            "state_ssm_re": state_ssm_re, "state_ssm_im": state_ssm_im,
            "norm_gain": norm_gain, "w_in": w_in, "b_f": b_f,
            "q_norm_gain": q_norm_gain, "k_norm_gain": k_norm_gain,
            "ssm_log_dt": ssm_log_dt, "ssm_a_re": ssm_a_re, "ssm_a_im": ssm_a_im,
            "ssm_b_re": ssm_b_re, "ssm_b_im": ssm_b_im, "ssm_c_re": ssm_c_re, "ssm_c_im": ssm_c_im,
            "ssm_d": ssm_d, "w_glu": w_glu, "b_glu": b_glu,
            "ssm_out_norm": ssm_out_norm, "att_out_norm": att_out_norm, "w_out": w_out}


def reference(x_prompt, x_sample, cache_k, cache_v, cache_logf, state_ssm_re, state_ssm_im,
              norm_gain, w_in, b_f, q_norm_gain, k_norm_gain, ssm_log_dt, ssm_a_re, ssm_a_im,
              ssm_b_re, ssm_b_im, ssm_c_re, ssm_c_im, ssm_d, w_glu, b_glu,
              ssm_out_norm, att_out_norm, w_out):
    xp, xs = x_prompt, x_sample
    kp_l, vp_l, fp_l, hrp_l, hip_l = [], [], [], [], []
    ks_l, vs_l, fs_l, hrs_l, his_l = [], [], [], [], []
    for l in range(DEPTH):
        params = (norm_gain[l], w_in[l], b_f[l], q_norm_gain[l], k_norm_gain[l], ssm_log_dt[l],
                  ssm_a_re[l], ssm_a_im[l], ssm_b_re[l], ssm_b_im[l], ssm_c_re[l], ssm_c_im[l],
                  ssm_d[l], w_glu[l], b_glu[l], ssm_out_norm[l], att_out_norm[l], w_out[l])
        xp, (kp, vp, fp, hrp, hip) = _layer(xp, params, None)
        xs, (kk, vv, ff, hrs, his) = _layer(
            xs, params, (cache_k[l], cache_v[l], cache_logf[l], state_ssm_re[l], state_ssm_im[l]))
        kp_l.append(kp); vp_l.append(vp); fp_l.append(fp); hrp_l.append(hrp); hip_l.append(hip)
        ks_l.append(kk); vs_l.append(vv); fs_l.append(ff); hrs_l.append(hrs); his_l.append(his)
    return (xp, xs,
            jnp.stack(kp_l), jnp.stack(vp_l), jnp.stack(fp_l), jnp.stack(hrp_l), jnp.stack(hip_l),
            jnp.stack(ks_l), jnp.stack(vs_l), jnp.stack(fs_l), jnp.stack(hrs_l), jnp.stack(his_l))
```

```cpp
#include <hip/hip_runtime.h>
#include <cstdio>
#include <cstdint>

constexpr int D_MODEL = 2048, DEPTH = 4, N_HEADS = 8, HEAD_DIM = 128, N_GROUPS = 64, STATE_DIM = 64, SSM_GROUP = 16;
constexpr int P_BATCH = 2, P_SEQ = 8192, S_BATCH = 32, S_SEQ = 64, PAST = 1024;
constexpr int MP = P_BATCH * P_SEQ;
constexpr int MS = S_BATCH * S_SEQ;
constexpr int MROWS = MP + MS;
constexpr int D_HALF = 1024, D_PROJ = 6152, N_IN = 6144;
constexpr int NSUB = MROWS / 16;
constexpr float EPS = 1e-6f;
constexpr float SQRT_HD = 11.313708498984761f;

constexpr size_t MiB = 1u << 20;
constexpr size_t WS_CTL = 0, CTL_ZERO_BYTES = 2 * MiB;
constexpr size_t WS_A16  = 2 * MiB;
constexpr size_t WS_WF   = 3 * MiB;
constexpr size_t WS_WIN  = 4 * MiB;
constexpr size_t WS_WGLU = WS_WIN + 4ull * N_IN * 2048 * 2;
constexpr size_t WS_WOUT = WS_WGLU + 4ull * 1024 * 1024 * 2;
constexpr size_t WS_WT   = WS_WOUT + 4ull * 2048 * 2048 * 2;
constexpr size_t WS_BC   = WS_WT + 4ull * 64 * 128 * 256 * 2;
constexpr size_t WS_XB   = WS_BC + 4ull * 64 * 256 * 384 * 2;
constexpr size_t WS_U    = WS_XB + (size_t)MROWS * 2048 * 2;
constexpr size_t WS_SZS  = WS_U + (size_t)MROWS * 1024 * 2;
constexpr size_t WS_Q    = WS_SZS + (size_t)MROWS * 1024 * 2;
constexpr size_t WS_K    = WS_Q + (size_t)MROWS * 1024 * 2;
constexpr size_t WS_V    = WS_K + (size_t)MROWS * 1024 * 2;
constexpr size_t WS_SZA  = WS_V + (size_t)MROWS * 1024 * 2;
constexpr size_t WS_ZS   = WS_SZA + (size_t)MROWS * 1024 * 2;
constexpr size_t WS_YN   = WS_ZS + (size_t)MROWS * 1024 * 2;
constexpr size_t WS_E16  = WS_YN + (size_t)MROWS * 2048 * 2;
constexpr size_t WS_HS   = WS_E16 + (size_t)NSUB * 64 * 128 * 4;
constexpr size_t WS_LOGF = WS_HS + (size_t)NSUB * 64 * 128 * 2;
constexpr size_t WS_KBP  = WS_LOGF + (size_t)MROWS * 8 * 4;
constexpr size_t WS_KBS  = WS_KBP + 16ull * 8192 * 16 * 2;
constexpr size_t WS_END  = WS_KBS + 256ull * 1088 * 16 * 2;
constexpr int CW_BAR = 4096;
constexpr int CW_ROWSQ = 65536;
static_assert((CW_ROWSQ + 5 * MROWS) * 4 <= (int)CTL_ZERO_BYTES, "CTL words inside the memset region");

constexpr size_t O_YP = 0, O_YS = O_YP + (size_t)MP * 2048, O_KP = O_YS + (size_t)MS * 2048, O_VP = O_KP + 4ull * MP * 1024, O_LFP = O_VP + 4ull * MP * 1024,
                 O_HRP = O_LFP + 4ull * MP * 8, O_HIP = O_HRP + 4ull * 2 * 64 * 64, O_KS = O_HIP + 4ull * 2 * 64 * 64, O_VS = O_KS + 4ull * MS * 1024, O_LFS = O_VS + 4ull * MS * 1024,
                 O_HRS = O_LFS + 4ull * MS * 8, O_HIS = O_HRS + 4ull * 32 * 64 * 64, O_END = O_HIS + 4ull * 32 * 64 * 64;
static_assert(O_END == 190447616ull, "output size");

#ifndef N_LAYERS_RUN
#define N_LAYERS_RUN 4
#endif
#define STAGE_ZERO_OUT 0
#ifndef ONE_LAUNCH
#define ONE_LAUNCH 0
#endif
namespace pg8 {
#define PG8_LAS __attribute__((address_space(3)))
typedef unsigned short bf16_t;
typedef short bf16x8 __attribute__((ext_vector_type(8)));
typedef float f32x4 __attribute__((ext_vector_type(4)));
typedef unsigned u32x4 __attribute__((ext_vector_type(4)));
constexpr int BM = 256, BK = 64, HALF = 128, HTB = HALF * BK * 2  , STAGE_BYTES = 8 * HTB, NXCD = 8, WGM = 8;

__host__ __device__ __forceinline__ int lds_byte(int r, int c) { const int st = (r >> 4) * 2 + (c >> 5), rr = r & 15, cc = c & 31, ob = rr * 64 + cc * 2; return st * 1024 + (ob ^ (((ob >> 9) & 1) << 5)); }
__host__ __device__ __forceinline__ void stage_rc(int b, int& R, int& C) { const int st = b / 1024, sb = b % 1024, swz = sb ^ (((sb >> 9) & 1) << 5); R = (st >> 1) * 16 + swz / 64; C = (st & 1) * 32 + (swz % 64) / 2; }
__host__ __device__ __forceinline__ int perm32(int rho) { const int n = rho >> 4, i = rho & 15; return 8 * (i >> 2) + 4 * n + (i & 3); }

struct Unit { int pm, pn; };
struct Gemm { const bf16_t* A; const bf16_t* Bt; int M, N, K; };

struct StaticOrder {
    int nM, nN, nwg, G, c;
    __host__ __device__ void init(int M, int N, int G_, int c_) { nM = M / BM; nN = N / BM; nwg = nM * nN; G = G_; c = c_; }
    __host__ __device__ bool next(int i, Unit& u) const {
        const long L = (long)i * G + c; if (L >= nwg) return false;
        int wgid = (int)L; { const int q = nwg / NXCD, r = nwg % NXCD, xcd = wgid % NXCD, off = wgid / NXCD; wgid = (xcd < r ? xcd * (q + 1) : r * (q + 1) + (xcd - r) * q) + off; }
        const int nig = WGM * nN, gid = wgid / nig, fm = gid * WGM, gsz = (nM - fm) < WGM ? (nM - fm) : WGM;
        u.pm = fm + ((wgid % nig) % gsz); u.pn = (wgid % nig) / gsz; return true;
    }
    __device__ __forceinline__ void a_ready(const Unit&) const {}
    __device__ __forceinline__ void done(const Unit&) const {}
};

__device__ __forceinline__ unsigned cvt_pk_bf16(float lo, float hi) { unsigned r; asm volatile("v_cvt_pk_bf16_f32 %0, %1, %2" : "=v"(r) : "v"(lo), "v"(hi)); return r; }
typedef float f32x2 __attribute__((ext_vector_type(2)));
__device__ __forceinline__ f32x2 gelu_pk(f32x2 v) {
    const f32x2 av = __builtin_elementwise_abs(v), d = av * 0.2316418882f + 1.0f;
    f32x2 t; t.x = __builtin_amdgcn_rcpf(d.x); t.y = __builtin_amdgcn_rcpf(d.y);
    f32x2 q = t * 0.5307027145f + (-0.7265760135f); q = q * t + 0.7107068705f; q = q * t + (-0.142248368f); q = q * t + 0.127414796f; q = q * t;
    const f32x2 s = (v * v) * (-0.72134752044f);
    f32x2 e; e.x = __builtin_amdgcn_exp2f(s.x); e.y = __builtin_amdgcn_exp2f(s.y);
    const f32x2 m = v * (q * e), r = v - m;
    f32x2 o; o.x = v.x < 0.f ? m.x : r.x; o.y = v.y < 0.f ? m.y : r.y; return o;
}

__device__ __forceinline__ float bf_lo(unsigned w) { return __uint_as_float(w << 16); }
__device__ __forceinline__ float bf_hi(unsigned w) { return __uint_as_float(w & 0xffff0000u); }
__device__ __forceinline__ float fast_sigmoid(float v) { return __builtin_amdgcn_rcpf(1.0f + __builtin_amdgcn_exp2f(-1.4426950408889634f * v)); }
__device__ __forceinline__ u32x4 pack8f(const f32x4 a, const f32x4 b) { u32x4 w; w.x = cvt_pk_bf16(a[0], a[1]); w.y = cvt_pk_bf16(a[2], a[3]); w.z = cvt_pk_bf16(b[0], b[1]); w.w = cvt_pk_bf16(b[2], b[3]); return w; }

struct EpiIn {
    static constexpr bool PERM = true, AFTER_DRAIN = false;
    unsigned char* ws; float* out; const float *qg, *kg; int l;
    PG8_LAS float* red;
    __device__ __forceinline__ void operator()(const f32x4 (&acc)[2][2][4][2], const Unit& u, int wr, int wc, int fr, int fq) const {
        const float* rowsq = (const float*)(ws + WS_CTL) + CW_ROWSQ + (size_t)l * MROWS;
        bf16_t* U = (bf16_t*)(ws + WS_U); bf16_t* SZS = (bf16_t*)(ws + WS_SZS); bf16_t* Q = (bf16_t*)(ws + WS_Q); bf16_t* K = (bf16_t*)(ws + WS_K); bf16_t* V = (bf16_t*)(ws + WS_V); bf16_t* SZA = (bf16_t*)(ws + WS_SZA);
        float* kout_p = out + O_KP + (size_t)l * MP * 1024; float* kout_s = out + O_KS + (size_t)l * MS * 1024; float* vout_p = out + O_VP + (size_t)l * MP * 1024; float* vout_s = out + O_VS + (size_t)l * MS * 1024;
        const int region = u.pn >> 2, ct = (u.pn & 3) * 256;
        const int rt = wr * 64 + fr, row0 = u.pm * BM + rt, cw = wc * 32 + 8 * fq;
        float rs[2][4];
#pragma unroll
        for (int ai = 0; ai < 2; ++ai)
#pragma unroll
            for (int m = 0; m < 4; ++m) rs[ai][m] = rsqrtf(rowsq[row0 + ai * HALF + m * 16] * (1.0f / 2048.0f) + EPS);
        if (region == 0) {
#pragma unroll
            for (int ai = 0; ai < 2; ++ai)
#pragma unroll
                for (int m = 0; m < 4; ++m) { const int row = row0 + ai * HALF + m * 16; const float s = rs[ai][m];
#pragma unroll
                    for (int bj = 0; bj < 2; ++bj) { const int col = ct + bj * HALF + cw; const int g = col >> 4, c0 = col & 15;
                        *(u32x4*)(U + ((size_t)g * MROWS + row) * 16 + c0) = pack8f(acc[ai][bj][m][0] * s, acc[ai][bj][m][1] * s); } }
        } else if (region == 1 || region == 5) {
            bf16_t* dst = region == 1 ? SZS : SZA;
#pragma unroll
            for (int ai = 0; ai < 2; ++ai)
#pragma unroll
                for (int m = 0; m < 4; ++m) { const int row = row0 + ai * HALF + m * 16; const float s = rs[ai][m];
#pragma unroll
                    for (int bj = 0; bj < 2; ++bj) { f32x4 a = acc[ai][bj][m][0] * s, b = acc[ai][bj][m][1] * s;
#pragma unroll
                        for (int i = 0; i < 4; ++i) { a[i] = a[i] * fast_sigmoid(a[i]); b[i] = b[i] * fast_sigmoid(b[i]); }
                        *(u32x4*)(dst + (size_t)row * 1024 + ct + bj * HALF + cw) = pack8f(a, b); } }
        } else if (region == 4) {
            float* vo = (u.pm < MP / BM) ? vout_p + (size_t)row0 * 1024 : vout_s + (size_t)(row0 - MP) * 1024;
#pragma unroll
            for (int ai = 0; ai < 2; ++ai)
#pragma unroll
                for (int m = 0; m < 4; ++m) { const int ro = ai * HALF + m * 16; const float s = rs[ai][m];
#pragma unroll
                    for (int bj = 0; bj < 2; ++bj) { const f32x4 a = acc[ai][bj][m][0] * s, b = acc[ai][bj][m][1] * s; const int col = ct + bj * HALF + cw;
                        *(u32x4*)(V + (size_t)(row0 + ro) * 1024 + col) = pack8f(a, b);
                        *(f32x4*)(vo + (size_t)ro * 1024 + col) = a; *(f32x4*)(vo + (size_t)ro * 1024 + col + 4) = b; } }
        } else {
#pragma unroll
            for (int ai = 0; ai < 2; ++ai)
#pragma unroll
                for (int m = 0; m < 4; ++m) { const float s = rs[ai][m];
#pragma unroll
                    for (int bj = 0; bj < 2; ++bj) { const f32x4 a = acc[ai][bj][m][0] * s, b = acc[ai][bj][m][1] * s;
                        float q = (a[0] * a[0] + a[1] * a[1]) + (a[2] * a[2] + a[3] * a[3]) + (b[0] * b[0] + b[1] * b[1]) + (b[2] * b[2] + b[3] * b[3]);
                        q += __shfl_xor(q, 16); q += __shfl_xor(q, 32);
                        if (fq == 0) red[((ai * HALF + wr * 64 + m * 16 + fr) * 2 + bj) * 4 + wc] = q; } }
            asm volatile("s_waitcnt lgkmcnt(0)" ::: "memory"); __builtin_amdgcn_s_barrier(); asm volatile("" ::: "memory");
            const float* gp = (region == 2 ? qg : kg) + cw;
            const f32x4 g0 = *(const f32x4*)gp, g1 = *(const f32x4*)(gp + 4);
            bf16_t* dst = region == 2 ? Q : K;
            float* ko = (u.pm < MP / BM) ? kout_p + (size_t)row0 * 1024 : kout_s + (size_t)(row0 - MP) * 1024;
#pragma unroll
            for (int ai = 0; ai < 2; ++ai)
#pragma unroll
                for (int m = 0; m < 4; ++m) { const int ro = ai * HALF + m * 16;
#pragma unroll
                    for (int bj = 0; bj < 2; ++bj) { const f32x4 t = *(const PG8_LAS f32x4*)(red + ((ai * HALF + wr * 64 + m * 16 + fr) * 2 + bj) * 4);
                        const float sc = rsqrtf(((t[0] + t[1]) + (t[2] + t[3])) * (1.0f / 128.0f) + EPS) * rs[ai][m];
                        const f32x4 a = acc[ai][bj][m][0] * sc * g0, b = acc[ai][bj][m][1] * sc * g1; const int col = ct + bj * HALF + cw;
                        *(u32x4*)(dst + (size_t)(row0 + ro) * 1024 + col) = pack8f(a, b);
                        if (region == 3) { *(f32x4*)(ko + (size_t)ro * 1024 + col) = a; *(f32x4*)(ko + (size_t)ro * 1024 + col + 4) = b; } } }
        }
    }
};

struct EpiGlu {
    static constexpr bool PERM = true, AFTER_DRAIN = false;
    unsigned char* ws; const float* bias;
    __device__ __forceinline__ void operator()(const f32x4 (&acc)[2][2][4][2], const Unit& u, int wr, int wc, int fr, int fq) const {
        const bf16_t* ZS = (const bf16_t*)(ws + WS_ZS); const bf16_t* SZS = (const bf16_t*)(ws + WS_SZS); bf16_t* YN = (bf16_t*)(ws + WS_YN);
        const int row0 = u.pm * BM + wr * 64 + fr, c0 = u.pn * BM + wc * 32 + 8 * fq;
#pragma unroll
        for (int bj = 0; bj < 2; ++bj) { const int col = c0 + bj * HALF; const f32x4 b0 = *(const f32x4*)(bias + col), b1 = *(const f32x4*)(bias + col + 4);
#pragma unroll
            for (int ai = 0; ai < 2; ++ai)
#pragma unroll
                for (int m = 0; m < 4; ++m) { const size_t row = (size_t)(row0 + ai * HALF + m * 16);
                    const u32x4 z = *(const u32x4*)(ZS + row * 1024 + col), s = *(const u32x4*)(SZS + row * 1024 + col);
                    const f32x4 v0 = acc[ai][bj][m][0] + b0, v1 = acc[ai][bj][m][1] + b1; f32x4 o0, o1;
                    o0[0] = bf_lo(z.x) * fast_sigmoid(v0[0]) * bf_lo(s.x); o0[1] = bf_hi(z.x) * fast_sigmoid(v0[1]) * bf_hi(s.x);
                    o0[2] = bf_lo(z.y) * fast_sigmoid(v0[2]) * bf_lo(s.y); o0[3] = bf_hi(z.y) * fast_sigmoid(v0[3]) * bf_hi(s.y);
                    o1[0] = bf_lo(z.z) * fast_sigmoid(v1[0]) * bf_lo(s.z); o1[1] = bf_hi(z.z) * fast_sigmoid(v1[1]) * bf_hi(s.z);
                    o1[2] = bf_lo(z.w) * fast_sigmoid(v1[2]) * bf_lo(s.w); o1[3] = bf_hi(z.w) * fast_sigmoid(v1[3]) * bf_hi(s.w);
                    *(u32x4*)(YN + row * 2048 + col) = pack8f(o0, o1); } }
    }
};

struct EpiOut {
    static constexpr bool PERM = true, AFTER_DRAIN = false;
    const float* xin_p; const float* xin_s; float* xout; unsigned char* ws; int l;
    __device__ __forceinline__ void operator()(const f32x4 (&acc)[2][2][4][2], const Unit& u, int wr, int wc, int fr, int fq) const {
        bf16_t* XB = (bf16_t*)(ws + WS_XB); float* rowsq_next = (float*)(ws + WS_CTL) + CW_ROWSQ + (size_t)(l + 1) * MROWS;
        const int row0 = u.pm * BM + wr * 64 + fr, c0 = u.pn * BM + wc * 32 + 8 * fq;
        const float* xi = (u.pm < MP / BM) ? xin_p + (size_t)row0 * 2048 : xin_s + (size_t)(row0 - MP) * 2048;
#pragma unroll
        for (int ai = 0; ai < 2; ++ai)
#pragma unroll
            for (int m = 0; m < 4; ++m) { const int ro = ai * HALF + m * 16; float ss = 0.f;
#pragma unroll
                for (int bj = 0; bj < 2; ++bj) { const int col = c0 + bj * HALF;
                    const f32x4 a = *(const f32x4*)(xi + (size_t)ro * 2048 + col) + acc[ai][bj][m][0], b = *(const f32x4*)(xi + (size_t)ro * 2048 + col + 4) + acc[ai][bj][m][1];
                    *(f32x4*)(xout + (size_t)(row0 + ro) * 2048 + col) = a; *(f32x4*)(xout + (size_t)(row0 + ro) * 2048 + col + 4) = b;
                    *(u32x4*)(XB + (size_t)(row0 + ro) * 2048 + col) = pack8f(a, b);
                    ss += (a[0] * a[0] + a[1] * a[1]) + (a[2] * a[2] + a[3] * a[3]) + (b[0] * b[0] + b[1] * b[1]) + (b[2] * b[2] + b[3] * b[3]); }
                ss += __shfl_xor(ss, 16); ss += __shfl_xor(ss, 32);
                if (fq == 0) unsafeAtomicAdd(rowsq_next + row0 + ro, ss); }
    }
};
template <class Epi, class Sched, bool ALIGN_EPI = false, bool SP2 = false>
__device__ __forceinline__ void gemm_phase(PG8_LAS unsigned char* lds, const Gemm g, const Sched& S, const Epi& E) {
    int tid_ = threadIdx.x; asm volatile("" : "+v"(tid_));
    const int tid = tid_, wid = __builtin_amdgcn_readfirstlane(tid >> 6), lane = tid & 63, wr = wid >> 2, wc = wid & 3, fr = lane & 15, fq = lane >> 4;
    const int K = g.K, nt = K / BK;
    unsigned voffA[2], voffB[2];
#pragma unroll
    for (int i = 0; i < 2; ++i) { int R, C; stage_rc(tid * 16 + i * 8192, R, C); const int Rb = Epi::PERM ? ((R & ~31) + perm32(R & 31)) : R;
        voffA[i] = (unsigned)(R * K + C) * 2u; voffB[i] = (unsigned)(Rb * K + C) * 2u; }
    const size_t kstep = (size_t)(BK * 2);
    const size_t hstep = (size_t)HALF * K * 2;
    const size_t tstep = 2 * hstep;
    const unsigned ldsw = (unsigned)wid * 1024u;
    const int aoff = lds_byte(wr * 64 + fr, fq * 8), boff = lds_byte(wc * 32 + fr, fq * 8);
#define PG8_SA(b, h) (((b) * 2 + (h)) * HTB)
#define PG8_SB(b, h) ((4 + (b) * 2 + (h)) * HTB)
#define PG8_STAGE(bufoff, gbase, voff) do { _Pragma("unroll") for (int _i = 0; _i < 2; ++_i) \
        __builtin_amdgcn_global_load_lds((const unsigned*)((const char*)(gbase) + (voff)[_i]), (PG8_LAS unsigned*)(lds + (bufoff) + ldsw + _i * 8192), 16, 0, 0); } while (0)
#define PG8_LDA(dst, b, h) do { _Pragma("unroll") for (int m = 0; m < 4; ++m) _Pragma("unroll") for (int k = 0; k < 2; ++k) dst[m][k] = *(const PG8_LAS bf16x8*)(lds + PG8_SA(b, h) + aoff + m * 2048 + k * 1024); } while (0)
#define PG8_LDB(dst, b, h) do { _Pragma("unroll") for (int n = 0; n < 2; ++n) _Pragma("unroll") for (int k = 0; k < 2; ++k) dst[n][k] = *(const PG8_LAS bf16x8*)(lds + PG8_SB(b, h) + boff + n * 2048 + k * 1024); } while (0)
#define PG8_MMA(ai, bj, At, Bt) do { __builtin_amdgcn_s_setprio(1); _Pragma("unroll") for (int m = 0; m < 4; ++m) _Pragma("unroll") for (int n = 0; n < 2; ++n) _Pragma("unroll") for (int k = 0; k < 2; ++k) \
        acc[ai][bj][m][n] = __builtin_amdgcn_mfma_f32_16x16x32_bf16(Bt[n][k], At[m][k], acc[ai][bj][m][n], 0, 0, 0); __builtin_amdgcn_s_setprio(0); } while (0)
#define PG8_WAIT_V(n) asm volatile("s_waitcnt vmcnt(" #n ")" ::: "memory")
#define PG8_WAIT_L(n) asm volatile("s_waitcnt lgkmcnt(" #n ")" ::: "memory")
#define PG8_BAR __builtin_amdgcn_s_barrier()
#define PG8_SCHED __builtin_amdgcn_sched_barrier(0)
    Unit cur, nxt; int ui = 0;
    if (!S.next(0, cur)) return;
    f32x4 acc[2][2][4][2];
#pragma unroll
    for (int a = 0; a < 2; ++a)
#pragma unroll
        for (int b = 0; b < 2; ++b)
#pragma unroll
            for (int m = 0; m < 4; ++m)
#pragma unroll
                for (int n = 0; n < 2; ++n) acc[a][b][m][n] = (f32x4){0.f, 0.f, 0.f, 0.f};
    bf16x8 At[4][2], B0[2][2], B1[2][2];
    const char* cA = (const char*)g.A + (size_t)cur.pm * tstep; const char* cB = (const char*)g.Bt + (size_t)cur.pn * tstep;
    S.a_ready(cur);
    if constexpr (SP2) {
        PG8_STAGE(PG8_SB(0, 0), cB, voffB); PG8_STAGE(PG8_SB(0, 1), cB + hstep, voffB); PG8_STAGE(PG8_SA(0, 0), cA, voffA); PG8_STAGE(PG8_SA(0, 1), cA + hstep, voffA);
        if (wr == 1) PG8_BAR;
        PG8_WAIT_V(2); PG8_BAR;
        PG8_STAGE(PG8_SB(1, 0), cB + kstep, voffB); PG8_STAGE(PG8_SA(1, 0), cA + kstep, voffA); PG8_STAGE(PG8_SB(1, 1), cB + hstep + kstep, voffB);
        PG8_WAIT_V(6); PG8_BAR;
    } else {
        PG8_STAGE(PG8_SB(0, 0), cB, voffB); PG8_STAGE(PG8_SA(0, 0), cA, voffA); PG8_STAGE(PG8_SB(0, 1), cB + hstep, voffB); PG8_STAGE(PG8_SA(0, 1), cA + hstep, voffA);
        if (wr == 1) PG8_BAR;
        PG8_WAIT_V(4); PG8_BAR;
        PG8_STAGE(PG8_SB(1, 0), cB + kstep, voffB); PG8_STAGE(PG8_SA(1, 0), cA + kstep, voffA); PG8_STAGE(PG8_SB(1, 1), cB + hstep + kstep, voffB);
        PG8_WAIT_V(6); PG8_BAR;
    }
    for (;;) {
        const bool has_next = S.next(ui + 1, nxt);
        const char* nA = has_next ? (const char*)g.A + (size_t)nxt.pm * tstep : cA; const char* nB = has_next ? (const char*)g.Bt + (size_t)nxt.pn * tstep : cB;
        for (int t = 0; t < nt; t += 2) {
            const bool last = (t == nt - 2);
            const char* a1 = cA + (size_t)(t + 1) * kstep;
            const char* a2 = last ? nA : cA + (size_t)(t + 2) * kstep; const char* b2 = last ? nB : cB + (size_t)(t + 2) * kstep;
            const char* a3 = a2 + kstep; const char* b3 = b2 + kstep;
            if (last && has_next) S.a_ready(nxt);
            if constexpr (SP2) {
            PG8_LDB(B0, 0, 0); PG8_LDB(B1, 0, 1); PG8_SCHED; PG8_LDA(At, 0, 0); PG8_STAGE(PG8_SA(1, 1), a1 + hstep, voffA);
            PG8_WAIT_V(8); PG8_WAIT_L(0); PG8_BAR; PG8_MMA(0, 0, At, B0); PG8_MMA(0, 1, At, B1); PG8_BAR; PG8_SCHED;
            PG8_LDA(At, 0, 1); PG8_STAGE(PG8_SB(0, 0), b2, voffB); PG8_STAGE(PG8_SB(0, 1), b2 + hstep, voffB); PG8_STAGE(PG8_SA(0, 0), a2, voffA);
            PG8_WAIT_V(8); PG8_WAIT_L(0); PG8_BAR; PG8_MMA(1, 0, At, B0); PG8_MMA(1, 1, At, B1); PG8_BAR; PG8_SCHED;
            PG8_LDB(B0, 1, 0); PG8_LDB(B1, 1, 1); PG8_SCHED; PG8_LDA(At, 1, 0); PG8_STAGE(PG8_SA(0, 1), a2 + hstep, voffA);
            PG8_WAIT_V(8); PG8_WAIT_L(0); PG8_BAR; PG8_MMA(0, 0, At, B0); PG8_MMA(0, 1, At, B1); PG8_BAR; PG8_SCHED;
            PG8_LDA(At, 1, 1); PG8_STAGE(PG8_SB(1, 0), b3, voffB); PG8_STAGE(PG8_SB(1, 1), b3 + hstep, voffB); PG8_STAGE(PG8_SA(1, 0), a3, voffA);
            PG8_WAIT_V(8); PG8_WAIT_L(0); PG8_BAR; PG8_MMA(1, 0, At, B0); PG8_MMA(1, 1, At, B1); PG8_BAR; PG8_SCHED;
            } else {
            PG8_LDB(B0, 0, 0); PG8_SCHED; PG8_LDA(At, 0, 0); PG8_STAGE(PG8_SA(1, 1), a1 + hstep, voffA);
            PG8_WAIT_L(8); PG8_BAR; PG8_WAIT_L(0); PG8_MMA(0, 0, At, B0); PG8_BAR; PG8_SCHED;
            PG8_LDB(B1, 0, 1); PG8_STAGE(PG8_SB(0, 0), b2, voffB);
            PG8_BAR; PG8_WAIT_L(0); PG8_MMA(0, 1, At, B1); PG8_BAR;
            PG8_LDA(At, 0, 1); PG8_STAGE(PG8_SA(0, 0), a2, voffA);
            PG8_BAR; PG8_WAIT_L(0); PG8_MMA(1, 0, At, B0); PG8_BAR; PG8_SCHED;
            PG8_STAGE(PG8_SB(0, 1), b2 + hstep, voffB);
            PG8_WAIT_V(6); PG8_BAR; PG8_MMA(1, 1, At, B1); PG8_BAR;
            PG8_LDB(B0, 1, 0); PG8_SCHED; PG8_LDA(At, 1, 0); PG8_STAGE(PG8_SA(0, 1), a2 + hstep, voffA);
            PG8_WAIT_L(8); PG8_BAR; PG8_WAIT_L(0); PG8_MMA(0, 0, At, B0); PG8_BAR; PG8_SCHED;
            PG8_LDB(B1, 1, 1); PG8_STAGE(PG8_SB(1, 0), b3, voffB);
            PG8_BAR; PG8_WAIT_L(0); PG8_MMA(0, 1, At, B1); PG8_BAR;
            PG8_LDA(At, 1, 1); PG8_STAGE(PG8_SA(1, 0), a3, voffA);
            PG8_BAR; PG8_WAIT_L(0); PG8_MMA(1, 0, At, B0); PG8_BAR; PG8_SCHED;
            PG8_STAGE(PG8_SB(1, 1), b3 + hstep, voffB);
            PG8_WAIT_V(6); PG8_BAR; PG8_MMA(1, 1, At, B1); PG8_BAR;
            }
        }
        if constexpr (ALIGN_EPI) { if (wr == 0) PG8_BAR; }
        if constexpr (!Epi::AFTER_DRAIN) { E(acc, cur, wr, wc, fr, fq); S.done(cur); }
        if (!has_next) break;
#pragma unroll
        for (int a = 0; a < 2; ++a)
#pragma unroll
            for (int b = 0; b < 2; ++b)
#pragma unroll
                for (int m = 0; m < 4; ++m)
#pragma unroll
                    for (int n = 0; n < 2; ++n) acc[a][b][m][n] = (f32x4){0.f, 0.f, 0.f, 0.f};
        cur = nxt; cA = nA; cB = nB; ++ui;
        if constexpr (ALIGN_EPI) { if (wr == 1) PG8_BAR; }
    }
    PG8_WAIT_V(0);
    if constexpr (!ALIGN_EPI) { if (wr == 0) PG8_BAR; }
    PG8_BAR;
    if constexpr (Epi::AFTER_DRAIN) { E.fused(acc, cur, wr, wc, fr, fq, lds, wid, lane); S.done(cur); }
#undef PG8_SA
#undef PG8_SB
#undef PG8_STAGE
#undef PG8_LDA
#undef PG8_LDB
#undef PG8_MMA
#undef PG8_WAIT_V
#undef PG8_WAIT_L
#undef PG8_BAR
#undef PG8_SCHED
}
}

constexpr int RING_OFF = 0, RING_BYTES = 131072;
constexpr int RED_OFF = RING_BYTES;
constexpr int MISC_OFF = RED_OFF + 8192;
constexpr int LDS_BYTES = 147456;
static_assert(MISC_OFF + 128 <= LDS_BYTES, "LDS map");
constexpr int NWAVES = 8;

#define GAS __attribute__((address_space(1)))
#define LAS __attribute__((address_space(3)))
typedef unsigned short bf16;
typedef unsigned v4u __attribute__((ext_vector_type(4)));
typedef unsigned v2u __attribute__((ext_vector_type(2)));
typedef float f32x4 __attribute__((ext_vector_type(4)));
typedef float f32x16 __attribute__((ext_vector_type(16)));
typedef short bf16x8 __attribute__((ext_vector_type(8)));
#define LDS_WAIT() asm volatile("s_waitcnt lgkmcnt(0)" ::: "memory")
#define VM_WAIT() asm volatile("s_waitcnt vmcnt(0)" ::: "memory")
__device__ __forceinline__ unsigned f2bf(float f) { unsigned u = __builtin_bit_cast(unsigned, f); return (u + 0x7fffu + ((u >> 16) & 1u)) >> 16; }
__device__ __forceinline__ unsigned pk2(float lo, float hi) { return f2bf(lo) | (f2bf(hi) << 16); }
__device__ __forceinline__ float bf2f(unsigned h) { return __uint_as_float(h << 16); }
__device__ __forceinline__ float wave_sum(float v) {
#pragma unroll
    for (int o = 1; o < 64; o <<= 1) v += __shfl_xor(v, o);
    return v;
}
#define XB_TMO      128
#define XB_XCNT(j)  (256  + 64 * (j))
#define XB_XSUB(j)  (1280 + 64 * (j))
#define XB_XGEN(j)  (2304 + 64 * (j))
#define XB_TOP      3328
#define XB_TOPGEN   3392
#define XCD_BAR_WORDS 3456
#define XB_SPIN_CAP (1u << 18)

__device__ __forceinline__ unsigned xb_ld(unsigned* p)              { return __hip_atomic_load(p, __ATOMIC_RELAXED, __HIP_MEMORY_SCOPE_AGENT); }
__device__ __forceinline__ unsigned xb_add(unsigned* p, unsigned v) { return __hip_atomic_fetch_add(p, v, __ATOMIC_RELAXED, __HIP_MEMORY_SCOPE_AGENT); }
__device__ __forceinline__ unsigned xb_xcc_id() { return (unsigned)__builtin_amdgcn_s_getreg((3 << 11) | 20) & 0xFu; }
#define XB_SPIN(cond, bar) do { unsigned _sp = 0; while (cond) { __builtin_amdgcn_s_sleep(1); \
    if ((++_sp & 255u) == 0u) { if (xb_ld(&(bar)[XB_TMO])) break; if (_sp > XB_SPIN_CAP) { atomicAdd(&(bar)[XB_TMO], 1u); break; } } } } while (0)

struct XcdBarrier {
    unsigned* bar; unsigned x;
    volatile LAS unsigned* st;
};

__device__ __forceinline__ XcdBarrier xcd_barrier_post(unsigned* bar, volatile LAS unsigned* st) {
    XcdBarrier b; b.bar = bar; b.x = xb_xcc_id(); b.st = st;
    if (threadIdx.x == 0) (void)xb_add(&bar[XB_XCNT(b.x)], 1u);
    return b;
}
__device__ __forceinline__ void xcd_barrier_complete(unsigned* bar, unsigned x, unsigned& nloc, unsigned& nx) {
    const unsigned G = gridDim.x * gridDim.y * gridDim.z;
    unsigned sum, cnt, mine, sp = 0u;
    for (;;) {
        sum = 0u; cnt = 0u; mine = 0u;
#pragma unroll
        for (unsigned j = 0; j < 16; ++j) { const unsigned c = xb_ld(&bar[XB_XCNT(j)]); sum += c; cnt += (c > 0u) ? 1u : 0u; mine = (j == x) ? c : mine; }
        if (sum == G) break;
        __builtin_amdgcn_s_sleep(1);
        if ((++sp & 255u) == 0u) { if (xb_ld(&bar[XB_TMO])) break; if (sp > XB_SPIN_CAP) { atomicAdd(&bar[XB_TMO], 1u); break; } }
    }
    nloc = mine > 0u ? mine : 1u; nx = cnt > 0u ? cnt : 1u;
}

__device__ __forceinline__ void xcd_barrier(const XcdBarrier& b) {
    asm volatile("s_waitcnt vmcnt(0)" ::: "memory");
    __syncthreads();
    if (threadIdx.x == 0) {
        unsigned* bar = b.bar;
        __builtin_amdgcn_s_waitcnt(0);
        unsigned nloc = b.st[0], nx = b.st[1];
        if (nloc == 0u) { xcd_barrier_complete(bar, b.x, nloc, nx); b.st[0] = nloc; b.st[1] = nx; }
        const unsigned old = xb_add(&bar[XB_XSUB(b.x)], 1u);
        const unsigned gen = old / nloc;
        if (old + 1u == (gen + 1u) * nloc) {
            __builtin_amdgcn_fence(__ATOMIC_RELEASE, "agent");
            asm volatile("s_waitcnt vmcnt(0)" ::: "memory");
            const unsigned og = xb_add(&bar[XB_TOP], 1u);
            const unsigned tg = og / nx;
            if (og + 1u == (tg + 1u) * nx) xb_add(&bar[XB_TOPGEN], 1u);
            else XB_SPIN(xb_ld(&bar[XB_TOPGEN]) == tg, bar);
            __builtin_amdgcn_fence(__ATOMIC_ACQUIRE, "agent");
            xb_add(&bar[XB_XGEN(b.x)], 1u);
            asm volatile("s_waitcnt vmcnt(0)" ::: "memory");
        } else {
            XB_SPIN(xb_ld(&bar[XB_XGEN(b.x)]) == gen, bar);
            __builtin_amdgcn_fence(__ATOMIC_ACQUIRE, "agent");
            asm volatile("s_waitcnt vmcnt(0)" ::: "memory");
        }
    }
    __syncthreads();
}

__device__ __forceinline__ int crow(int r, int hi) { return (r & 3) + 8 * (r >> 2) + 4 * hi; }
#define MFMA32(a, b, c) __builtin_amdgcn_mfma_f32_32x32x16_bf16((a), (b), (c), 0, 0, 0)
#define MFMA16(a, b, c) __builtin_amdgcn_mfma_f32_16x16x32_bf16((a), (b), (c), 0, 0, 0)

__device__ __forceinline__ void dsincos(double x, double& s, double& c) {
    const double k = __builtin_rint(x * 0.63661977236758134308);
    double r = __builtin_fma(-k, 1.57079632679489655800e+00, x); r = __builtin_fma(-k, 6.12323399573676603587e-17, r);
    const double r2 = r * r;
    double sp = -7.6471637318198164759e-13;
    sp = sp * r2 + 1.6059043836821614599e-10; sp = sp * r2 - 2.5052108385441718775e-08; sp = sp * r2 + 2.7557319223985890653e-06;
    sp = sp * r2 - 1.9841269841269841270e-04; sp = sp * r2 + 8.3333333333333333333e-03; sp = sp * r2 - 1.6666666666666666667e-01;
    const double sr = r + r * r2 * sp;
    double cp = 4.7794773323873852974e-14;
    cp = cp * r2 - 1.1470745597729724714e-11; cp = cp * r2 + 2.0876756987868098979e-09; cp = cp * r2 - 2.7557319223985890653e-07;
    cp = cp * r2 + 2.4801587301587301587e-05; cp = cp * r2 - 1.3888888888888888889e-03; cp = cp * r2 + 4.1666666666666666667e-02; cp = cp * r2 - 0.5;
    const double cr = 1.0 + r2 * cp;
    const int q = ((int)k) & 3;
    s = (q == 0) ? sr : (q == 1) ? cr : (q == 2) ? -sr : -cr;
    c = (q == 0) ? cr : (q == 1) ? -sr : (q == 2) ? -cr : sr;
}

__device__ __forceinline__ void p0_transpose_item(const float* W, int ldw, int K, bf16* WT, const float* gain, LAS float* scr, int kb, int nb, int lane) {
    const int k0 = 64 * kb, n0 = 32 * nb;
#pragma unroll 8
    for (int i = 0; i < 32; ++i) { const int kk = 2 * i + (lane >> 5); float v = W[(size_t)(k0 + kk) * ldw + n0 + (lane & 31)]; if (gain) v *= gain[k0 + kk]; scr[kk * 33 + (lane & 31)] = v; }
    LDS_WAIT(); asm volatile("" ::: "memory");
    const int c = lane & 7;
#pragma unroll
    for (int j = 0; j < 4; ++j) { const int n = (lane >> 3) + 8 * j; const LAS float* s = scr + (8 * c) * 33 + n;
        v4u o; o.x = pk2(s[0 * 33], s[1 * 33]); o.y = pk2(s[2 * 33], s[3 * 33]); o.z = pk2(s[4 * 33], s[5 * 33]); o.w = pk2(s[6 * 33], s[7 * 33]);
        *(GAS v4u*)(WT + (size_t)(n0 + n) * K + k0 + 8 * c) = o; }
    LDS_WAIT(); asm volatile("" ::: "memory");
}

__device__ __forceinline__ void p0_s5_item(int l, int g, const float* const* in, bf16* WT, bf16* BC, float* A16, LAS float* scr, int tid) {
    LAS float* PWR = scr; LAS float* PWI = scr + 1088; LAS float* BPR = scr + 2176; LAS float* BPI = scr + 3200;
    LAS float* CR = scr + 4224; LAS float* CI = scr + 5248; LAS float* KL = scr + 6272; LAS float* DD = scr + 10368;
    const int lg = l * 64 + g;
    if (tid < 64) {
        const int p = tid;
        const double dt = exp((double)in[12][lg]);
        const double ar = (double)in[13][lg * 64 + p], ai = (double)in[14][lg * 64 + p];
        const double mag = exp(ar * dt); double sn, cs; dsincos(ai * dt, sn, cs);
        const double abr = mag * cs, abi = mag * sn;
        const double den = ar * ar + ai * ai, nr = abr - 1.0, ni = abi;
        const double cfr = (nr * ar + ni * ai) / den, cfi = (ni * ar - nr * ai) / den;
        double pr = 1.0, pi = 0.0;
        for (int n = 0; n <= 16; ++n) { PWR[n * 64 + p] = (float)pr; PWI[n * 64 + p] = (float)pi; const double t = pr * abr - pi * abi; pi = pr * abi + pi * abr; pr = t; }
        A16[(g * 64 + p) * 2] = PWR[16 * 64 + p]; A16[(g * 64 + p) * 2 + 1] = PWI[16 * 64 + p];
        const float* br = in[15] + ((size_t)lg * 64 + p) * 16; const float* bi = in[16] + ((size_t)lg * 64 + p) * 16;
        for (int c = 0; c < 16; ++c) { const double x = br[c], y = bi[c]; BPR[p * 16 + c] = (float)(cfr * x - cfi * y); BPI[p * 16 + c] = (float)(cfr * y + cfi * x); }
    } else {
        for (int i = tid - 64; i < 1024; i += 448) { CR[i] = in[17][(size_t)lg * 1024 + i]; CI[i] = in[18][(size_t)lg * 1024 + i]; }
        if (tid < 80) DD[tid - 64] = in[19][lg * 16 + tid - 64];
    }
    __syncthreads();
    for (int o = tid; o < 4096; o += 512) { const int lag = o >> 8, c = (o >> 4) & 15, cp = o & 15; float a = 0.f;
        for (int p = 0; p < 64; ++p) { const float pr = PWR[lag * 64 + p], pi = PWI[lag * 64 + p], br = BPR[p * 16 + cp], bi = BPI[p * 16 + cp];
            a += CR[c * 64 + p] * (pr * br - pi * bi) - CI[c * 64 + p] * (pr * bi + pi * br); }
        if (lag == 0 && c == cp) a += DD[c];
        KL[o] = a; }
    __syncthreads();
    bf16* bc = BC + (size_t)g * 256 * 384;
    for (int q = tid; q < 12288; q += 512) { const int n = q / 48, k0 = (q % 48) * 8, t = n >> 4, c = n & 15; float v[8];
        if (k0 < 256) { const int s = k0 >> 4, cp0 = k0 & 15;
#pragma unroll
            for (int e = 0; e < 8; ++e) v[e] = (s <= t) ? KL[(t - s) * 256 + c * 16 + cp0 + e] : 0.f;
        } else { const int kk0 = k0 - 256; const bool im = kk0 >= 64; const int p0 = im ? kk0 - 64 : kk0;
#pragma unroll
            for (int e = 0; e < 8; ++e) { const int p = p0 + e; const float cr = CR[c * 64 + p], ci = CI[c * 64 + p], pr = PWR[(t + 1) * 64 + p], pi = PWI[(t + 1) * 64 + p];
                v[e] = im ? -(cr * pi + ci * pr) : (cr * pr - ci * pi); } }
        v4u o; o.x = pk2(v[0], v[1]); o.y = pk2(v[2], v[3]); o.z = pk2(v[4], v[5]); o.w = pk2(v[6], v[7]);
        *(GAS v4u*)(bc + (size_t)n * 384 + k0) = o; }
    bf16* wt = WT + (size_t)g * 128 * 256;
    for (int q = tid; q < 4096; q += 512) { const int n = q >> 5, k0 = (q & 31) * 8, s = k0 >> 4, cp0 = k0 & 15, p = n & 63; const bool im = n >= 64; float v[8];
        const float pr = PWR[(15 - s) * 64 + p], pi = PWI[(15 - s) * 64 + p];
#pragma unroll
        for (int e = 0; e < 8; ++e) { const float br = BPR[p * 16 + cp0 + e], bi = BPI[p * 16 + cp0 + e]; v[e] = im ? (pr * bi + pi * br) : (pr * br - pi * bi); }
        v4u o; o.x = pk2(v[0], v[1]); o.y = pk2(v[2], v[3]); o.z = pk2(v[4], v[5]); o.w = pk2(v[6], v[7]);
        *(GAS v4u*)(wt + (size_t)n * 256 + k0) = o; }
    __syncthreads();
}

__device__ __forceinline__ void p0_row_item(const float* xrow, bf16* orow, float* rsq, int lane) {
    const GAS f32x4* xr = (const GAS f32x4*)xrow + lane; GAS v2u* o8 = (GAS v2u*)orow + lane; float s = 0.f;
#pragma unroll
    for (int j = 0; j < 8; ++j) { const f32x4 v = xr[64 * j]; s += (v[0] * v[0] + v[1] * v[1]) + (v[2] * v[2] + v[3] * v[3]); v2u w; w.x = pk2(v[0], v[1]); w.y = pk2(v[2], v[3]); o8[64 * j] = w; }
    s = wave_sum(s);
    if (lane == 0) *rsq = s;
}

__device__ __forceinline__ void p0_prologue(const float* const* in, unsigned char* ws, LAS unsigned char* lds, int tid, int wave, int lane, int vcu, int G) {
    for (int it = vcu; it < DEPTH * 64; it += G) { const int l = it >> 6, g = it & 63;
        p0_s5_item(l, g, in, (bf16*)(ws + WS_WT) + (size_t)l * 64 * 128 * 256, (bf16*)(ws + WS_BC) + (size_t)l * 64 * 256 * 384, (float*)(ws + WS_A16) + (size_t)l * 64 * 64 * 2, (LAS float*)(lds + RING_OFF), tid); }
    LAS float* scr = (LAS float*)(lds + RING_OFF + wave * 16384);
    const int gw = vcu * NWAVES + wave, NGW = G * NWAVES;
    constexpr int I_IN = 32 * 192, I_GLU = 16 * 32, I_OUT = 32 * 64, PER_L = I_IN + I_GLU + I_OUT;
    for (int it = gw; it < DEPTH * PER_L; it += NGW) { const int l = it / PER_L; int r = it - l * PER_L;
        if (r < I_IN) { p0_transpose_item(in[8] + (size_t)l * 2048 * D_PROJ, D_PROJ, 2048, (bf16*)(ws + WS_WIN) + (size_t)l * N_IN * 2048, in[7] + l * 2048, scr, r / 192, r % 192, lane); continue; } r -= I_IN;
        if (r < I_GLU) { p0_transpose_item(in[20] + (size_t)l * 1024 * 1024, 1024, 1024, (bf16*)(ws + WS_WGLU) + (size_t)l * 1024 * 1024, nullptr, scr, r / 32, r % 32, lane); continue; } r -= I_GLU;
        { const int kb = r / 64; const float* gn = (kb < 16) ? in[22] + l * 1024 : in[23] + l * 1024 - 1024;
          p0_transpose_item(in[24] + (size_t)l * 2048 * 2048, 2048, 2048, (bf16*)(ws + WS_WOUT) + (size_t)l * 2048 * 2048, gn, scr, kb, r % 64, lane); } }
    for (int it = gw; it < DEPTH * 16; it += NGW) { const int l = it >> 4, h = it & 15; bf16* wf = (bf16*)(ws + WS_WF) + (size_t)it * 2048;
        for (int k = lane; k < 2048; k += 64) { const float v = (h < 8) ? in[7][l * 2048 + k] * in[8][((size_t)l * 2048 + k) * D_PROJ + N_IN + h] : 0.f; wf[k] = (bf16)f2bf(v); } }
    float* rowsq0 = (float*)(ws + WS_CTL) + CW_ROWSQ;
    for (int m = gw; m < MROWS; m += NGW) { const float* xr = (m < MP) ? in[0] + (size_t)m * 2048 : in[1] + (size_t)(m - MP) * 2048;
        p0_row_item(xr, (bf16*)(ws + WS_XB) + (size_t)m * 2048, rowsq0 + m, lane); }
}

__device__ __forceinline__ float log_sigmoid(float x) { return (x >= 0.f) ? -log1pf(expf(-x)) : x - log1pf(expf(x)); }

__device__ __forceinline__ void fpre_item(int item, const bf16* XB, const bf16* WF, const float* rowsq, const float* bfv, float* LOGF, float* out_p, float* out_s, int lane) {
    const int row0 = item * 16, fr = lane & 15, fq = lane >> 4;
    const bf16* a = XB + (size_t)(row0 + fr) * 2048 + 8 * fq; const bf16* b = WF + (size_t)fr * 2048 + 8 * fq;
    f32x4 acc = {0.f, 0.f, 0.f, 0.f};
#pragma unroll 8
    for (int kk = 0; kk < 64; ++kk) { const bf16x8 av = *(const bf16x8*)(a + kk * 32), bv = *(const bf16x8*)(b + kk * 32); acc = MFMA16(av, bv, acc); }
    if (fr < 8) {
#pragma unroll
        for (int i = 0; i < 4; ++i) { const int row = row0 + 4 * fq + i; const float rs = rsqrtf(rowsq[row] * (1.0f / 2048.0f) + EPS);
            const float lf = log_sigmoid(acc[i] * rs + bfv[fr]); LOGF[row * 8 + fr] = lf;
            if (row < MP) out_p[row * 8 + fr] = lf; else out_s[(row - MP) * 8 + fr] = lf; } }
}

__device__ __forceinline__ void e16_item(int item, const bf16* U, const bf16* WT, float* E16, int lane) {
    const int nh = item & 1, t2 = item >> 1, jb = t2 % 36, g = t2 / 36, r32 = lane & 31, hi = lane >> 5;
    const bf16* bp = U + ((size_t)g * MROWS + (size_t)(jb * 32 + r32) * 16) * 16 + 8 * hi;
    const bf16* ap = WT + ((size_t)(g * 128 + nh * 64 + r32)) * 256 + 8 * hi;
    f32x16 acc0 = {}, acc1 = {};
#pragma unroll 4
    for (int s = 0; s < 16; ++s) { const bf16x8 b = *(const bf16x8*)(bp + 16 * s); const bf16x8 a0 = *(const bf16x8*)(ap + 16 * s), a1 = *(const bf16x8*)(ap + 32 * 256 + 16 * s);
        acc0 = MFMA32(a0, b, acc0); acc1 = MFMA32(a1, b, acc1); }
    float* ep = E16 + ((size_t)(jb * 32 + r32) * 64 + g) * 128 + nh * 64 + 4 * hi;
#pragma unroll
    for (int rq = 0; rq < 4; ++rq) { *(f32x4*)(ep + 8 * rq) = (f32x4){acc0[4 * rq], acc0[4 * rq + 1], acc0[4 * rq + 2], acc0[4 * rq + 3]};
        *(f32x4*)(ep + 32 + 8 * rq) = (f32x4){acc1[4 * rq], acc1[4 * rq + 1], acc1[4 * rq + 2], acc1[4 * rq + 3]}; }
}

__device__ __forceinline__ void carry_prompt_item(int item, const float* E16, const float* A16, bf16* HS, float* out_re, float* out_im, LAS float* scr, int wave, int lane) {
    const int b = item >> 6, g = item & 63, p = lane;
    const float ar = A16[(g * 64 + p) * 2], ai = A16[(g * 64 + p) * 2 + 1];
    const int j0 = b * 512 + wave * 64;
    const float* ep = E16 + ((size_t)j0 * 64 + g) * 128 + p;
    float hr = 0.f, hm = 0.f;
#pragma unroll 1
    for (int jb = 0; jb < 2; ++jb) { float er[32], ei[32];
#pragma unroll
        for (int j = 0; j < 32; ++j) { er[j] = ep[(size_t)(jb * 32 + j) * 8192]; ei[j] = ep[(size_t)(jb * 32 + j) * 8192 + 64]; }
#pragma unroll
        for (int j = 0; j < 32; ++j) { const float nr = ar * hr - ai * hm + er[j], ni = ar * hm + ai * hr + ei[j]; hr = nr; hm = ni; } }
    scr[(wave * 64 + p) * 2] = hr; scr[(wave * 64 + p) * 2 + 1] = hm;
    float sr = ar, si = ai;
#pragma unroll
    for (int q = 0; q < 6; ++q) { const float t = sr * sr - si * si; si = 2.f * sr * si; sr = t; }
    LDS_WAIT(); __syncthreads();
    float cr = 0.f, ci = 0.f;
    for (int v = 0; v < wave; ++v) { const float xr = scr[(v * 64 + p) * 2], xi = scr[(v * 64 + p) * 2 + 1]; const float nr = sr * cr - si * ci + xr, ni = sr * ci + si * cr + xi; cr = nr; ci = ni; }
    bf16* hp = HS + ((size_t)j0 * 64 + g) * 128 + p;
    hr = cr; hm = ci; asm volatile("" ::: "memory");
#pragma unroll 1
    for (int jb = 0; jb < 2; ++jb) { float er[32], ei[32];
#pragma unroll
        for (int j = 0; j < 32; ++j) { er[j] = ep[(size_t)(jb * 32 + j) * 8192]; ei[j] = ep[(size_t)(jb * 32 + j) * 8192 + 64]; }
#pragma unroll
        for (int j = 0; j < 32; ++j) { hp[(size_t)(jb * 32 + j) * 8192] = (bf16)f2bf(hr); hp[(size_t)(jb * 32 + j) * 8192 + 64] = (bf16)f2bf(hm);
            const float nr = ar * hr - ai * hm + er[j], ni = ar * hm + ai * hr + ei[j]; hr = nr; hm = ni; } }
    if (wave == 7) { out_re[(b * 64 + g) * 64 + p] = hr; out_im[(b * 64 + g) * 64 + p] = hm; }
    __syncthreads();
}
__device__ __forceinline__ void carry_sample_item(int item, const float* E16, const float* A16, const float* h0r, const float* h0i, bf16* HS, float* out_re, float* out_im, int lane) {
    const int b = item >> 6, g = item & 63, p = lane;
    const float ar = A16[(g * 64 + p) * 2], ai = A16[(g * 64 + p) * 2 + 1];
    const int j0 = MP / 16 + b * 4;
    const float* ep = E16 + ((size_t)j0 * 64 + g) * 128 + p; bf16* hp = HS + ((size_t)j0 * 64 + g) * 128 + p;
    float hr = h0r[(b * 64 + g) * 64 + p], hm = h0i[(b * 64 + g) * 64 + p];
#pragma unroll
    for (int j = 0; j < 4; ++j) { hp[(size_t)j * 8192] = (bf16)f2bf(hr); hp[(size_t)j * 8192 + 64] = (bf16)f2bf(hm);
        const float xr = ep[(size_t)j * 8192], xi = ep[(size_t)j * 8192 + 64]; const float nr = ar * hr - ai * hm + xr, ni = ar * hm + ai * hr + xi; hr = nr; hm = ni; }
    out_re[(b * 64 + g) * 64 + p] = hr; out_im[(b * 64 + g) * 64 + p] = hm;
}

__device__ __forceinline__ void store_kb(bf16* kp, float c) {
    const float val = -c * SQRT_HD; const unsigned h0 = f2bf(val); const float r1 = val - bf2f(h0); const unsigned h1 = f2bf(r1); const float r2 = r1 - bf2f(h1); const unsigned h2 = f2bf(r2);
    v4u a; a.x = h0 | (h1 << 16); a.y = h2; a.z = 0u; a.w = 0u; v4u z = {0u, 0u, 0u, 0u};
    *(GAS v4u*)kp = a; *(GAS v4u*)(kp + 8) = z;
}
__device__ __forceinline__ void cumsum_prompt_item(int item, const float* LOGF, bf16* KBP, LAS float* scr, int tid, int wave, int lane) {
    const int b = item >> 3, h = item & 7;
    const float* lp = LOGF + ((size_t)(b * P_SEQ + tid * 16)) * 8 + h;
    float v[16];
#pragma unroll
    for (int i = 0; i < 16; ++i) v[i] = lp[i * 8];
    float run = 0.f;
#pragma unroll
    for (int i = 0; i < 16; ++i) { run += v[i]; v[i] = run; }
    float x = run;
#pragma unroll
    for (int o = 1; o < 64; o <<= 1) { const float y = __shfl_up(x, o); if (lane >= o) x += y; }
    if (lane == 63) scr[wave] = x;
    LDS_WAIT(); __syncthreads();
    float base = x - run;
    for (int w = 0; w < wave; ++w) base += scr[w];
    bf16* kp = KBP + ((size_t)item * P_SEQ + tid * 16) * 16;
#pragma unroll
    for (int i = 0; i < 16; ++i) store_kb(kp + i * 16, base + v[i]);
    __syncthreads();
}
__device__ __forceinline__ void cumsum_sample_item(int item, const float* cache_logf  , const float* LOGF, bf16* KBS, int lane) {
    const int b = item >> 3, h = item & 7;
    float v[17]; float run = 0.f;
#pragma unroll
    for (int i = 0; i < 17; ++i) { const int s = lane * 17 + i; const float x = (s < PAST) ? cache_logf[((size_t)b * PAST + s) * 8 + h] : LOGF[((size_t)(MP + b * S_SEQ + s - PAST)) * 8 + h]; run += x; v[i] = run; }
    float x = run;
#pragma unroll
    for (int o = 1; o < 64; o <<= 1) { const float y = __shfl_up(x, o); if (lane >= o) x += y; }
    const float base = x - run;
    bf16* kp = KBS + ((size_t)item * (PAST + S_SEQ) + lane * 17) * 16;
#pragma unroll
    for (int i = 0; i < 17; ++i) store_kb(kp + i * 16, base + v[i]);
}

__device__ __forceinline__ void sc_item(int item, const bf16* U, const bf16* HS, const bf16* BC, bf16* ZS, int lane) {
    const int nq = item & 1, t2 = item >> 1, jb = t2 % 36, g = t2 / 36, r32 = lane & 31, hi = lane >> 5, j = jb * 32 + r32;
    const bf16* bu = U + ((size_t)g * MROWS + (size_t)j * 16) * 16 + 8 * hi;
    const bf16* bh = HS + ((size_t)j * 64 + g) * 128 + 8 * hi;
    const bf16* ap = BC + ((size_t)(g * 256 + nq * 128 + r32)) * 384 + 8 * hi;
    f32x16 acc0 = {}, acc1 = {}, acc2 = {}, acc3 = {};
#pragma unroll 4
    for (int s = 0; s < 16; ++s) { const bf16x8 b = *(const bf16x8*)(bu + 16 * s);
        const bf16x8 a0 = *(const bf16x8*)(ap + 16 * s), a1 = *(const bf16x8*)(ap + 32 * 384 + 16 * s), a2 = *(const bf16x8*)(ap + 64 * 384 + 16 * s), a3 = *(const bf16x8*)(ap + 96 * 384 + 16 * s);
        acc0 = MFMA32(a0, b, acc0); acc1 = MFMA32(a1, b, acc1); acc2 = MFMA32(a2, b, acc2); acc3 = MFMA32(a3, b, acc3); }
#pragma unroll 4
    for (int s = 0; s < 8; ++s) { const bf16x8 b = *(const bf16x8*)(bh + 16 * s); const bf16* aq = ap + 256 + 16 * s;
        const bf16x8 a0 = *(const bf16x8*)(aq), a1 = *(const bf16x8*)(aq + 32 * 384), a2 = *(const bf16x8*)(aq + 64 * 384), a3 = *(const bf16x8*)(aq + 96 * 384);
        acc0 = MFMA32(a0, b, acc0); acc1 = MFMA32(a1, b, acc1); acc2 = MFMA32(a2, b, acc2); acc3 = MFMA32(a3, b, acc3); }
#define SC_STORE(ACC, nb) do { _Pragma("unroll") for (int rq = 0; rq < 4; ++rq) { const int n0 = nq * 128 + (nb) * 32 + 8 * rq + 4 * hi; const int t = n0 >> 4, c0 = n0 & 15; \
        const pg8::f32x2 ga = pg8::gelu_pk((pg8::f32x2){ACC[4 * rq], ACC[4 * rq + 1]}), gb = pg8::gelu_pk((pg8::f32x2){ACC[4 * rq + 2], ACC[4 * rq + 3]}); \
        v2u w; w.x = pg8::cvt_pk_bf16(ga.x, ga.y); w.y = pg8::cvt_pk_bf16(gb.x, gb.y); *(GAS v2u*)(ZS + (size_t)(16 * j + t) * 1024 + g * 16 + c0) = w; } } while (0)
    SC_STORE(acc0, 0); SC_STORE(acc1, 1); SC_STORE(acc2, 2); SC_STORE(acc3, 3);
#undef SC_STORE
}

__device__ __forceinline__ float sumsq8(v4u a) { float s = 0.f;
    s += bf2f(a.x & 0xffffu) * bf2f(a.x & 0xffffu) + __uint_as_float(a.x & 0xffff0000u) * __uint_as_float(a.x & 0xffff0000u);
    s += bf2f(a.y & 0xffffu) * bf2f(a.y & 0xffffu) + __uint_as_float(a.y & 0xffff0000u) * __uint_as_float(a.y & 0xffff0000u);
    s += bf2f(a.z & 0xffffu) * bf2f(a.z & 0xffffu) + __uint_as_float(a.z & 0xffff0000u) * __uint_as_float(a.z & 0xffff0000u);
    s += bf2f(a.w & 0xffffu) * bf2f(a.w & 0xffffu) + __uint_as_float(a.w & 0xffff0000u) * __uint_as_float(a.w & 0xffff0000u);
    return s; }
__device__ __forceinline__ unsigned scale2(unsigned w, float s) { return pk2(bf2f(w & 0xffffu) * s, __uint_as_float(w & 0xffff0000u) * s); }
__device__ __forceinline__ v4u scale8(v4u a, float s) { v4u o; o.x = scale2(a.x, s); o.y = scale2(a.y, s); o.z = scale2(a.z, s); o.w = scale2(a.w, s); return o; }
__device__ __forceinline__ void norm_row_item(bf16* yrow, int lane) {
    GAS v4u* p = (GAS v4u*)yrow + lane;
    const v4u a0 = p[0], a1 = p[64], b0 = p[128], b1 = p[192];
    const float ss = wave_sum(sumsq8(a0) + sumsq8(a1)), sa = wave_sum(sumsq8(b0) + sumsq8(b1));
    const float rs = rsqrtf(ss * (1.0f / 1024.0f) + EPS), ra = rsqrtf(sa * (1.0f / 1024.0f) + EPS);
    p[0] = scale8(a0, rs); p[64] = scale8(a1, rs); p[128] = scale8(b0, ra); p[192] = scale8(b1, ra);
}

namespace fox {
constexpr int NW = 8, QBLK = 32, KVBLK = 64, QB = NW * QBLK, D = 128, PITCH = 1024;
constexpr int SHM_V = KVBLK * D * 2, SHM_K = KVBLK * D * 2;
constexpr int LDS_ATT = 2 * SHM_V + 2 * SHM_K + NW * 64 * 4;
constexpr float SCALE = 0.08838834764831845f, THR = 8.f;
typedef short s16x4 __attribute__((ext_vector_type(4)));
#define KSWZ(row, colB) ((row) * 256 + ((colB) ^ (((row) & 7) << 4)))
#define SBAR() __builtin_amdgcn_sched_barrier(0)
__device__ __forceinline__ int v_st(int k, int c) { const int kk = (k & ~0xC) | ((k & 4) << 1) | ((k & 8) >> 1); return ((kk >> 3) * 4 + (c >> 5)) * 512 + ((kk & 7) * 32 + (c & 31)) * 2; }
__device__ __forceinline__ int v_rd_base(int lane) { return ((lane & 3) << 3) | (((lane >> 2) & 3) << 6) | (((lane >> 4) & 1) << 5) | (((lane >> 5) & 1) << 8); }
constexpr int v_rd_off(int d0, int ks, int half) { return d0 * 512 + ks * 4096 + half * 2048; }
__device__ __forceinline__ unsigned cvtpk(float lo, float hi) { unsigned r; asm volatile("v_cvt_pk_bf16_f32 %0, %1, %2" : "=v"(r) : "v"(lo), "v"(hi)); return r; }
__device__ __forceinline__ bf16x8 pack8(f32x4 a, f32x4 b) { v4u w = {cvtpk(a[0], a[1]), cvtpk(a[2], a[3]), cvtpk(b[0], b[1]), cvtpk(b[2], b[3])}; return *reinterpret_cast<bf16x8*>(&w); }
__device__ __forceinline__ bf16x8 ld8(const bf16* p) { return *reinterpret_cast<const bf16x8*>(p); }
__device__ __forceinline__ void mask_tile(f32x16& p0, f32x16& p1, int dq) {
    const float NEG = -__builtin_inff();
#pragma unroll
    for (int r = 0; r < 16; ++r) { const int c = (r & 3) + 8 * (r >> 2); if (dq - c < 0) p0[r] = NEG; if (dq - c - 32 < 0) p1[r] = NEG; }
}
__device__ __forceinline__ void partialSM(f32x16& p0, f32x16& p1, float& m_reg, float& mn, float& alpha) {
    float pmax = p0[0];
#pragma unroll
    for (int r = 1; r < 16; ++r) pmax = fmaxf(pmax, p0[r]);
#pragma unroll
    for (int r = 0; r < 16; ++r) pmax = fmaxf(pmax, p1[r]);
    { auto rr = __builtin_amdgcn_permlane32_swap(__float_as_uint(pmax), __float_as_uint(pmax), false, false); pmax = fmaxf(__uint_as_float(rr[0]), __uint_as_float(rr[1])); }
    constexpr float C2 = 1.4426950408889634f * SCALE;
    if (__builtin_expect(__all((pmax - m_reg) * SCALE <= THR), 1)) { mn = m_reg; alpha = 1.f; }
    else { mn = fmaxf(m_reg, pmax); alpha = __builtin_amdgcn_exp2f((m_reg - mn) * C2); m_reg = mn; }
    const float mnL = -mn * C2;
#pragma unroll
    for (int r = 0; r < 16; ++r) p0[r] = fmaf(p0[r], C2, mnL);
#pragma unroll
    for (int r = 0; r < 16; ++r) p1[r] = fmaf(p1[r], C2, mnL);
#pragma unroll
    for (int r = 0; r < 16; ++r) p0[r] = __builtin_amdgcn_exp2f(p0[r]);
}
__device__ __forceinline__ void finishSM(f32x16& p0, f32x16& p1, float alpha, float& l_reg, bf16x8& pa0, bf16x8& pa1, bf16x8& pa2, bf16x8& pa3) {
#pragma unroll
    for (int r = 0; r < 16; ++r) p1[r] = __builtin_amdgcn_exp2f(p1[r]);
    float ps = 0;
#pragma unroll
    for (int r = 0; r < 16; ++r) ps += p0[r];
#pragma unroll
    for (int r = 0; r < 16; ++r) ps += p1[r];
    { auto rr = __builtin_amdgcn_permlane32_swap(__float_as_uint(ps), __float_as_uint(ps), false, false); ps = __uint_as_float(rr[0]) + __uint_as_float(rr[1]); }
    l_reg = l_reg * alpha + ps;
#define PK4(P, B_, OUT) do { unsigned a0 = cvtpk(P[B_+0], P[B_+1]), a1 = cvtpk(P[B_+2], P[B_+3]); unsigned b0 = cvtpk(P[B_+4], P[B_+5]), b1 = cvtpk(P[B_+6], P[B_+7]); \
        auto r0 = __builtin_amdgcn_permlane32_swap(a0, b0, false, false); auto r1 = __builtin_amdgcn_permlane32_swap(a1, b1, false, false); \
        v4u w = {r0[0], r1[0], r0[1], r1[1]}; OUT = *reinterpret_cast<bf16x8*>(&w); } while (0)
    PK4(p0, 0, pa0); PK4(p0, 8, pa1); PK4(p1, 0, pa2); PK4(p1, 8, pa3);
#undef PK4
}
__device__ __forceinline__ void qkt(f32x16& p0, f32x16& p1, const char* Kt, int r32, int hi, const bf16x8* qr, const bf16* kbp, bf16x8 qone) {
    const bf16x8 kb0 = ld8(kbp), kb1 = ld8(kbp + 32 * 16);
    p0 = f32x16{}; p1 = f32x16{};
    const char* kb[4];
#pragma unroll
    for (int dd = 0; dd < 4; ++dd) kb[dd] = Kt + KSWZ(r32, (dd * 16 + hi * 8) * 2);
#pragma unroll
    for (int d0 = 0; d0 < 8; ++d0) { const char* a = kb[d0 & 3] + (d0 >> 2) * 128;
        bf16x8 b0 = *reinterpret_cast<const bf16x8*>(a); bf16x8 b1 = *reinterpret_cast<const bf16x8*>(a + 32 * 256);
        p0 = MFMA32(b0, qr[d0], p0); p1 = MFMA32(b1, qr[d0], p1); }
    p0 = MFMA32(kb0, qone, p0); p1 = MFMA32(kb1, qone, p1);
}
template <int VOFF>
__device__ __forceinline__ void pv_tile(f32x16* o, int vb0, bf16x8 pa0, bf16x8 pa1, bf16x8 pa2, bf16x8 pa3) {
#define TRRD(dst, off) asm volatile("ds_read_b64_tr_b16 %0, %1 offset:%2" : "=&v"(dst) : "v"(vb0), "i"(off) : "memory")
#define PV_D0(d0) do { s16x4 l0, l1, l2, l3, h0, h1, h2, h3; constexpr int b_ = VOFF + v_rd_off(d0, 0, 0); \
        TRRD(l0, b_); TRRD(h0, b_ + 2048); TRRD(l1, b_ + 4096); TRRD(h1, b_ + 6144); TRRD(l2, b_ + 8192); TRRD(h2, b_ + 10240); TRRD(l3, b_ + 12288); TRRD(h3, b_ + 14336); \
        asm volatile("s_waitcnt lgkmcnt(0)" ::: "memory"); SBAR(); \
        o[d0] = MFMA32(pa0, ((bf16x8){l0[0], l0[1], l0[2], l0[3], h0[0], h0[1], h0[2], h0[3]}), o[d0]); \
        o[d0] = MFMA32(pa1, ((bf16x8){l1[0], l1[1], l1[2], l1[3], h1[0], h1[1], h1[2], h1[3]}), o[d0]); \
        o[d0] = MFMA32(pa2, ((bf16x8){l2[0], l2[1], l2[2], l2[3], h2[0], h2[1], h2[2], h2[3]}), o[d0]); \
        o[d0] = MFMA32(pa3, ((bf16x8){l3[0], l3[1], l3[2], l3[3], h3[0], h3[1], h3[2], h3[3]}), o[d0]); } while (0)
    PV_D0(0); PV_D0(1); PV_D0(2); PV_D0(3);
#undef PV_D0
#undef TRRD
}
__device__ __forceinline__ void store_o(const f32x16* o, const float* li_l, const bf16* SZw, bf16* Ow, int r32, int hi) {
    float rli[16];
#pragma unroll
    for (int r = 0; r < 16; ++r) rli[r] = __builtin_amdgcn_rcpf(li_l[crow(r, hi)]);
#pragma unroll
    for (int r = 0; r < 16; ++r) { const int orow = crow(r, hi);
#pragma unroll
        for (int d0 = 0; d0 < 4; ++d0) { const float z = bf2f(SZw[(size_t)orow * PITCH + d0 * 32 + r32]); const float v = o[d0][r] * rli[r] * z;
            const float vn = __shfl_xor(v, 1);
            if ((r32 & 1) == 0) *(unsigned*)(Ow + (size_t)orow * 2048 + d0 * 32 + r32) = cvtpk(v, vn); } }
}

struct BlockRef { const bf16* Q; const bf16* K; const bf16* V; const bf16* KB; const bf16* SZ; bf16* O; int P0; };
struct Seam { bf16x8 qr[8]; bf16x8 st_v0, st_v1, st_k0, st_k1; };
#define ROW(p, k0, rr) ((p) + (unsigned)(((k0) + (rr)) * PITCH + sc))
#define VMW() asm volatile("s_waitcnt vmcnt(0)" ::: "memory")
#define VMWN(n) asm volatile("s_waitcnt vmcnt(%0)" :: "i"(n) : "memory")
#define SLOAD_H(Kp, Vp, k0) do { S.st_v0 = ld8(ROW(Vp, k0, sr)); S.st_v1 = ld8(ROW(Vp, k0, 32 + sr)); S.st_k0 = ld8(ROW(Kp, k0, sr)); S.st_k1 = ld8(ROW(Kp, k0, 32 + sr)); } while (0)
#define SWRITE_HK(bf) do { *(bf16x8*)(K_lds + (bf) * SHM_K + kws) = S.st_k0; *(bf16x8*)(K_lds + (bf) * SHM_K + kws + 32 * 256) = S.st_k1; } while (0)
#define SWRITE_HV(bf) do { *(bf16x8*)(V_lds + (bf) * SHM_V + vst0) = S.st_v0; *(bf16x8*)(V_lds + (bf) * SHM_V + vst1) = S.st_v1; } while (0)
#define SWRITE_H(bf) do { SWRITE_HV(bf); SWRITE_HK(bf); } while (0)
__device__ __forceinline__ void fox_prime(const BlockRef& cur, char* lds, Seam& S) {
    int tid_ = threadIdx.x; asm volatile("" : "+v"(tid_));
    const int tid = tid_, wid = __builtin_amdgcn_readfirstlane(tid >> 6), lane = tid & 63, r32 = lane & 31, hi = lane >> 5;
    const int sr = tid >> 4, sc = (tid & 15) * 8, kws = KSWZ(sr, sc * 2); char* K_lds = lds + 2 * SHM_V;
#pragma unroll
    for (int d0 = 0; d0 < 8; ++d0) S.qr[d0] = ld8(cur.Q + (size_t)(wid * QBLK + r32) * PITCH + d0 * 16 + hi * 8);
    SLOAD_H(cur.K, cur.V, 0); VMW(); SWRITE_HK(0);
    __syncthreads();
}
__device__ __forceinline__ void fox_block(const BlockRef& cur, const BlockRef& nxt, char* lds, Seam& S, bf16x8 qone) {
    int tid_ = threadIdx.x; asm volatile("" : "+v"(tid_));
    const int tid = tid_, wid = __builtin_amdgcn_readfirstlane(tid >> 6), lane = tid & 63, r32 = lane & 31, hi = lane >> 5;
    const int NT = (cur.P0 + QB - 1) / KVBLK + 1;
    const int qlo = cur.P0 + wid * QBLK, qm = qlo + r32 - 4 * hi;
    char* V_lds = lds; char* K_lds = lds + 2 * SHM_V;
    float* ws = (float*)(lds + 2 * SHM_V + 2 * SHM_K) + wid * 64; float* li_l = ws, * al_l = ws + 32;
    float m_reg = -1e30f, l_reg = 0; f32x16 o[4] = {};
    const int sr = tid >> 4, sc = (tid & 15) * 8, vst0 = v_st(sr, sc), vst1 = v_st(32 + sr, sc), kws = KSWZ(sr, sc * 2);
    const int vb0 = (int)(uintptr_t)V_lds + v_rd_base(lane);
    const bf16* Kh = cur.K; const bf16* Vh = cur.V; const bf16* KBh = cur.KB; const unsigned kbl = (unsigned)(r32 * 16 + hi * 8);
#define RESC(a) do { if (__any((a) < 1.f)) { if (hi == 0) al_l[r32] = (a); asm volatile("s_waitcnt lgkmcnt(0)" ::: "memory"); \
                     _Pragma("unroll") for (int d_ = 0; d_ < 4; ++d_) _Pragma("unroll") for (int r = 0; r < 16; ++r) o[d_][r] *= al_l[crow(r, hi)]; } } while (0)
#define KBASE(t) ((t) * KVBLK)
#define MASKT(P0_, P1_, t) do { const int kb_ = KBASE(t); if (kb_ + KVBLK - 1 > qlo) mask_tile(P0_, P1_, qm - kb_); } while (0)
    constexpr int NQL = 8;
#define SEAM_K0() do { VMWN(NQL); SWRITE_HK(0); SBAR(); } while (0)
    f32x16 pA0, pA1, pB0, pB1; float mnA, mnB, alA, alB; bf16x8 pa0, pa1, pa2, pa3;
    SWRITE_HV(0); SBAR();
    if (NT > 1) SLOAD_H(Kh, Vh, KBASE(1));
    SBAR(); qkt(pA0, pA1, K_lds, r32, hi, S.qr, KBh + kbl, qone);
    MASKT(pA0, pA1, 0); partialSM(pA0, pA1, m_reg, mnA, alA);
    if (NT > 1) { VMW(); SWRITE_H(1); }
    __syncthreads();
#define HALF_STEP(PX0, PX1, mnX, alX, PY0, PY1, alY, t, KBI, VBI, SBI) do { \
        SBAR(); qkt(PX0, PX1, K_lds + (KBI) * SHM_K, r32, hi, S.qr, KBh + (kbl + (unsigned)KBASE(t) * 16u), qone); \
        finishSM(PY0, PY1, alY, l_reg, pa0, pa1, pa2, pa3); SBAR(); \
        if ((t) + 1 < NT) { SLOAD_H(Kh, Vh, KBASE((t) + 1)); SBAR(); } \
        pv_tile<(VBI) * SHM_V>(o, vb0, pa0, pa1, pa2, pa3); MASKT(PX0, PX1, (t)); partialSM(PX0, PX1, m_reg, mnX, alX); \
        __syncthreads(); \
        if ((t) + 1 < NT) { VMW(); SWRITE_H(SBI); } \
        RESC(alX); __syncthreads(); } while (0)
    for (int t = 1; t + 1 < NT; t += 2) {
        HALF_STEP(pB0, pB1, mnB, alB, pA0, pA1, alA, t, 1, 0, 0);
        HALF_STEP(pA0, pA1, mnA, alA, pB0, pB1, alB, t + 1, 0, 1, 1);
    }
    const bool even = (NT & 1) == 0;
    if (even) { SBAR(); qkt(pB0, pB1, K_lds + SHM_K, r32, hi, S.qr, KBh + (kbl + (unsigned)KBASE(NT - 1) * 16u), qone); SBAR(); }
    SLOAD_H(nxt.K, nxt.V, 0); SBAR();
#pragma unroll
    for (int d0 = 0; d0 < 8; ++d0) S.qr[d0] = ld8(nxt.Q + (size_t)(wid * QBLK + r32) * PITCH + d0 * 16 + hi * 8);
    SBAR();
    finishSM(pA0, pA1, alA, l_reg, pa0, pa1, pa2, pa3); SBAR();
    pv_tile<0>(o, vb0, pa0, pa1, pa2, pa3);
    if (even) { MASKT(pB0, pB1, NT - 1); partialSM(pB0, pB1, m_reg, mnB, alB); __syncthreads(); RESC(alB);
        finishSM(pB0, pB1, alB, l_reg, pa0, pa1, pa2, pa3); SBAR(); pv_tile<SHM_V>(o, vb0, pa0, pa1, pa2, pa3); }
    SBAR(); SEAM_K0();
    if (hi == 0) li_l[r32] = l_reg; asm volatile("s_waitcnt lgkmcnt(0)" ::: "memory");
    store_o(o, li_l, cur.SZ + (size_t)(wid * QBLK) * PITCH, cur.O + (size_t)(wid * QBLK) * 2048, r32, hi);
    __syncthreads();
#undef RESC
#undef KBASE
#undef MASKT
#undef SEAM_K0
#undef HALF_STEP
}
__device__ __forceinline__ BlockRef prompt_ref(int bh, int qb, const bf16* Qb, const bf16* Kb, const bf16* Vb, const bf16* KBP, const bf16* SZA, bf16* YN) {
    const int b = bh >> 3, h = bh & 7; const size_t row0 = (size_t)b * P_SEQ + (size_t)qb * QB; BlockRef r;
    r.Q = Qb + row0 * PITCH + h * D; r.K = Kb + (size_t)b * P_SEQ * PITCH + h * D; r.V = Vb + (size_t)b * P_SEQ * PITCH + h * D; r.KB = KBP + (size_t)bh * P_SEQ * 16;
    r.SZ = SZA + row0 * PITCH + h * D; r.O = YN + row0 * 2048 + 1024 + h * D; r.P0 = qb * QB; return r;
}
__device__ __forceinline__ void prompt_attn(int first, int G, const bf16* Qb, const bf16* Kb, const bf16* Vb, const bf16* KBP, const bf16* SZA, bf16* YN, char* lds, bf16x8 qone) {
    int L = first; if (L >= 256) return;
    Seam S; int pass = 0; BlockRef cur = prompt_ref(L >> 4, L & 15, Qb, Kb, Vb, KBP, SZA, YN);
    fox_prime(cur, lds, S);
    for (;;) {
        const bool more_pass = pass == 0, more_item = L + G < 256, last = !more_pass && !more_item;
        int Ln = L, passn = pass + 1; if (!more_pass) { passn = 0; Ln = more_item ? L + G : L; }
        const int yn = Ln & 15; const BlockRef nxt = last ? cur : prompt_ref(Ln >> 4, passn ? 31 - yn : yn, Qb, Kb, Vb, KBP, SZA, YN);
        fox_block(cur, nxt, lds, S, qone);
        if (last) break;
        cur = nxt; pass = passn; L = Ln;
    }
}

__device__ __forceinline__ void fox_sample_unit(int b, int h, const float* cK, const float* cV, const bf16* Kb, const bf16* Vb, const bf16* Qb, const bf16* KBS, const bf16* SZA, bf16* YN, char* lds, bf16x8 qone) {
    int tid_ = threadIdx.x; asm volatile("" : "+v"(tid_));
    const int tid = tid_, wid = __builtin_amdgcn_readfirstlane(tid >> 6), lane = tid & 63, r32 = lane & 31, hi = lane >> 5;
    const int sr = tid >> 4, sc = (tid & 15) * 8, vst0 = v_st(sr, sc), vst1 = v_st(32 + sr, sc), kws = KSWZ(sr, sc * 2);
    char* V_lds = lds; char* K_lds = lds + 2 * SHM_V;
    float* ws = (float*)(lds + 2 * SHM_V + 2 * SHM_K) + wid * 64; float* li_l = ws, * al_l = ws + 32;
    const int vb0 = (int)(uintptr_t)V_lds + v_rd_base(lane);
    const size_t rowq = (size_t)MP + (size_t)b * S_SEQ;
    const float* ck = cK + ((size_t)b * PAST) * 1024 + h * D + sc; const float* cv = cV + ((size_t)b * PAST) * 1024 + h * D + sc;
    const bf16* nk = Kb + rowq * PITCH + h * D + sc; const bf16* nv = Vb + rowq * PITCH + h * D + sc;
    const bf16* kbp = KBS + ((size_t)(b * 8 + h) * (PAST + S_SEQ) + r32) * 16 + hi * 8;
    const int wq = wid & 1;
    bf16x8 qr[8];
#pragma unroll
    for (int d0 = 0; d0 < 8; ++d0) qr[d0] = ld8(Qb + (rowq + wq * 32 + r32) * PITCH + h * D + d0 * 16 + hi * 8);
    float m_reg = -1e30f, l_reg = 0; f32x16 o[4] = {};
    f32x4 kf0, kf1, kf2, kf3, vf0, vf1, vf2, vf3;
#define LOADF(t) do { const float* kp_ = ck + (size_t)((t) * KVBLK + sr) * 1024; const float* vp_ = cv + (size_t)((t) * KVBLK + sr) * 1024; \
        kf0 = *(const f32x4*)kp_; kf1 = *(const f32x4*)(kp_ + 4); kf2 = *(const f32x4*)(kp_ + 32 * 1024); kf3 = *(const f32x4*)(kp_ + 32 * 1024 + 4); \
        vf0 = *(const f32x4*)vp_; vf1 = *(const f32x4*)(vp_ + 4); vf2 = *(const f32x4*)(vp_ + 32 * 1024); vf3 = *(const f32x4*)(vp_ + 32 * 1024 + 4); } while (0)
#define WRITEF(bf) do { *(bf16x8*)(K_lds + (bf) * SHM_K + kws) = pack8(kf0, kf1); *(bf16x8*)(K_lds + (bf) * SHM_K + kws + 32 * 256) = pack8(kf2, kf3); \
        *(bf16x8*)(V_lds + (bf) * SHM_V + vst0) = pack8(vf0, vf1); *(bf16x8*)(V_lds + (bf) * SHM_V + vst1) = pack8(vf2, vf3); } while (0)
#define LOADH() do { kf0 = *(const f32x4*)(nk + (size_t)sr * PITCH); kf1 = *(const f32x4*)(nk + (size_t)(32 + sr) * PITCH); vf0 = *(const f32x4*)(nv + (size_t)sr * PITCH); vf1 = *(const f32x4*)(nv + (size_t)(32 + sr) * PITCH); } while (0)
#define WRITEH(bf) do { *(f32x4*)(K_lds + (bf) * SHM_K + kws) = kf0; *(f32x4*)(K_lds + (bf) * SHM_K + kws + 32 * 256) = kf1; \
        *(f32x4*)(V_lds + (bf) * SHM_V + vst0) = vf0; *(f32x4*)(V_lds + (bf) * SHM_V + vst1) = vf1; } while (0)
#define RESC(a) do { if (__any((a) < 1.f)) { if (hi == 0) al_l[r32] = (a); asm volatile("s_waitcnt lgkmcnt(0)" ::: "memory"); \
                     _Pragma("unroll") for (int d_ = 0; d_ < 4; ++d_) _Pragma("unroll") for (int r = 0; r < 16; ++r) o[d_][r] *= al_l[crow(r, hi)]; } } while (0)
    constexpr int NTS = PAST / KVBLK + 1;
    LOADF(0);
    VMW(); WRITEF(0); __syncthreads();
#pragma unroll 1
    for (int t = 0; t < NTS; t += 2) {
#define SSTEP(tt, BUF) do { \
        if ((tt) + 1 < NTS - 1) { LOADF((tt) + 1); } else if ((tt) + 1 == NTS - 1) { LOADH(); } \
        if (wid < 2) { f32x16 p0, p1; float mn, al; bf16x8 pa0, pa1, pa2, pa3; \
            qkt(p0, p1, K_lds + (BUF) * SHM_K, r32, hi, qr, kbp + (size_t)((tt) * KVBLK) * 16, qone); \
            if ((tt) == NTS - 1) mask_tile(p0, p1, wid * QBLK + r32 - 4 * hi); \
            partialSM(p0, p1, m_reg, mn, al); RESC(al); finishSM(p0, p1, al, l_reg, pa0, pa1, pa2, pa3); SBAR(); \
            pv_tile<(BUF) * SHM_V>(o, vb0, pa0, pa1, pa2, pa3); } \
        if ((tt) + 1 < NTS) { VMW(); if ((tt) + 1 < NTS - 1) { WRITEF((BUF) ^ 1); } else { WRITEH((BUF) ^ 1); } } \
        __syncthreads(); } while (0)
        SSTEP(t, 0);
        if (t + 1 < NTS) SSTEP(t + 1, 1);
#undef SSTEP
    }
    if (wid < 2) { if (hi == 0) li_l[r32] = l_reg; asm volatile("s_waitcnt lgkmcnt(0)" ::: "memory");
        store_o(o, li_l, SZA + (rowq + wid * QBLK) * PITCH + h * D, YN + (rowq + wid * QBLK) * 2048 + 1024 + h * D, r32, hi); }
    __syncthreads();
#undef LOADF
#undef WRITEF
#undef LOADH
#undef WRITEH
#undef RESC
}
#undef ROW
#undef VMW
#undef VMWN
#undef SLOAD_H
#undef SWRITE_HK
#undef SWRITE_HV
#undef SWRITE_H
#undef KSWZ
#undef SBAR
}
#define STAGE_B_PHASES \
          \
        if (IN(ph + 3)) { PHASE_PTRS; const bf16* BCl = (const bf16*)(ws + WS_BC) + (size_t)l * 64 * 256 * 384; \
            for (int it = gw; it < 64 * 36 * 2; it += NGW) sc_item(it, Ub, HS, BCl, ZS, lane); } \
        SEAM(ph + 3); \
          \
        if (IN(ph + 4)) { PHASE_PTRS; \
            pg8::Gemm g{ZS, (const bf16*)(ws + WS_WGLU) + (size_t)l * 1024 * 1024, MROWS, 1024, 1024}; pg8::StaticOrder S; S.init(MROWS, 1024, G, (int)blockIdx.x); \
            pg8::EpiGlu E{ws, inp[21] + l * 1024}; \
            pg8::gemm_phase<pg8::EpiGlu, pg8::StaticOrder, true, true>(lds + RING_OFF, g, S, E); \
        } \
        SEAM(ph + 4); \
          \
        if (IN(ph + 5)) { PHASE_PTRS; \
            bf16x8 qone = {0, 0, 0, 0, 0, 0, 0, 0}; if ((tid & 32) == 0) { qone[0] = (short)0x3F80; qone[1] = (short)0x3F80; qone[2] = (short)0x3F80; } \
            for (int u = vcu; u < 256; u += G) fox::fox_sample_unit(u >> 3, u & 7, inp[2] + (size_t)l * 32 * PAST * 1024, inp[3] + (size_t)l * 32 * PAST * 1024, Kb, Vb, Qb, KBS, SZA, YN, (char*)lds_raw, qone); \
            fox::prompt_attn(vcu, G, Qb, Kb, Vb, KBP, SZA, YN, (char*)lds_raw, qone); \
        } \
        SEAM(ph + 5); \
          \
        if (IN(ph + 6)) { PHASE_PTRS; for (int m = gw; m < MROWS; m += NGW) norm_row_item(YN + (size_t)m * 2048, lane); } \
        SEAM(ph + 6); \
          \
        if (IN(ph + 7)) { PHASE_PTRS; \
            pg8::Gemm g{YN, (const bf16*)(ws + WS_WOUT) + (size_t)l * 2048 * 2048, MROWS, 2048, 2048}; pg8::StaticOrder S; S.init(MROWS, 2048, G, (int)blockIdx.x); \
            pg8::EpiOut E{l == 0 ? inp[0] : (const float*)out, l == 0 ? inp[1] : (const float*)(out + O_YS), out, ws, l}; \
            pg8::gemm_phase<pg8::EpiOut, pg8::StaticOrder, true, true>(lds + RING_OFF, g, S, E); \
        } \
        SEAM(ph + 7); \


constexpr int PH_PER_LAYER = 8, N_PHASES = 1 + DEPTH * PH_PER_LAYER;

struct Args { const float* in[25]; float* out; unsigned char* ws; int ph_lo, ph_hi; };
__global__ void __launch_bounds__(NWAVES * 64, 2) fwd_kernel(Args args) {
    extern __shared__ __attribute__((aligned(16))) unsigned char lds_raw[];
    LAS unsigned char* lds = (LAS unsigned char*)lds_raw;
    const int tid0 = threadIdx.x;
    const int G = gridDim.x; const int bx = blockIdx.x; const int vcu = (G % 8 == 0) ? (bx % 8) * (G / 8) + bx / 8 : bx;
    unsigned* ctl = (unsigned*)(args.ws + WS_CTL);
    volatile LAS unsigned* MISC = (volatile LAS unsigned*)(lds + MISC_OFF);
    if (tid0 < 32) MISC[tid0] = 0u;
    __syncthreads();
    const int lo = args.ph_lo, hi = args.ph_hi;
    const bool multi = (hi - lo) > 1;
    XcdBarrier bar; bar.bar = ctl + CW_BAR; bar.x = 0; bar.st = nullptr;
    if (multi) bar = xcd_barrier_post(ctl + CW_BAR, MISC + 8);
#define IN(k) (lo <= (k) && (k) < hi)
#define SEAM(k) do { if (IN(k) && IN((k) + 1)) xcd_barrier(bar); } while (0)
#define PHASE_PTRS int z_ = 0; int tid = tid0; asm volatile("" : "+s"(z_), "+v"(tid)); const int lane = tid & 63, wave = __builtin_amdgcn_readfirstlane(tid >> 6), gw = vcu * NWAVES + wave, NGW = G * NWAVES; (void)lane; (void)gw; (void)NGW; const float* const* inp = args.in + z_; unsigned char* ws = args.ws + z_; float* out = args.out + z_; float* rowsq = (float*)(ws + WS_CTL) + CW_ROWSQ; (void)inp; (void)out; (void)rowsq
#define XB ((bf16*)(ws + WS_XB))
#define Ub ((bf16*)(ws + WS_U))
#define SZS ((bf16*)(ws + WS_SZS))
#define Qb ((bf16*)(ws + WS_Q))
#define Kb ((bf16*)(ws + WS_K))
#define Vb ((bf16*)(ws + WS_V))
#define SZA ((bf16*)(ws + WS_SZA))
#define ZS ((bf16*)(ws + WS_ZS))
#define YN ((bf16*)(ws + WS_YN))
#define E16 ((float*)(ws + WS_E16))
#define HS ((bf16*)(ws + WS_HS))
#define LOGF ((float*)(ws + WS_LOGF))
#define KBP ((bf16*)(ws + WS_KBP))
#define KBS ((bf16*)(ws + WS_KBS))

    if (IN(0)) { PHASE_PTRS; p0_prologue(inp, ws, lds, tid, wave, lane, vcu, G); }
    SEAM(0);

    for (int l = 0; l < N_LAYERS_RUN; ++l) {
        const int ph = 1 + l * PH_PER_LAYER;
        if (IN(ph + 0)) { PHASE_PTRS;
            pg8::Gemm g{XB, (const bf16*)(ws + WS_WIN) + (size_t)l * N_IN * 2048, MROWS, N_IN, 2048}; pg8::StaticOrder S; S.init(MROWS, N_IN, G, (int)blockIdx.x);
            pg8::EpiIn E{ws, out, inp[10] + l * 128, inp[11] + l * 128, l, (LAS float*)(lds + RED_OFF)};
            pg8::gemm_phase<pg8::EpiIn, pg8::StaticOrder, true, true>(lds + RING_OFF, g, S, E);
        }
        SEAM(ph + 0);
        if (IN(ph + 1)) { PHASE_PTRS;
            const bf16* WTl = (const bf16*)(ws + WS_WT) + (size_t)l * 64 * 128 * 256;
            for (int it = gw; it < 64 * 36 * 2; it += NGW) e16_item(it, Ub, WTl, E16, lane);
            for (int it = gw; it < MROWS / 16; it += NGW) fpre_item(it, XB, (const bf16*)(ws + WS_WF) + (size_t)l * 16 * 2048, rowsq + (size_t)l * MROWS, inp[9] + l * 8, LOGF,
                                                                out + O_LFP + (size_t)l * MP * 8, out + O_LFS + (size_t)l * MS * 8, lane);
        }
        SEAM(ph + 1);
        if (IN(ph + 2)) { PHASE_PTRS;
            const float* A16l = (const float*)(ws + WS_A16) + (size_t)l * 64 * 64 * 2;
            for (int it = vcu; it < 128 + 16; it += G) {
                if (it < 128) carry_prompt_item(it, E16, A16l, HS, out + O_HRP + (size_t)l * 2 * 64 * 64, out + O_HIP + (size_t)l * 2 * 64 * 64, (LAS float*)(lds + RING_OFF), wave, lane);
                else cumsum_prompt_item(it - 128, LOGF, KBP, (LAS float*)(lds + RING_OFF), tid, wave, lane);
            }
            for (int it = gw; it < 2048 + 256; it += NGW) {
                if (it < 2048) carry_sample_item(it, E16, A16l, inp[5] + (size_t)l * 32 * 64 * 64, inp[6] + (size_t)l * 32 * 64 * 64, HS, out + O_HRS + (size_t)l * 32 * 64 * 64, out + O_HIS + (size_t)l * 32 * 64 * 64, lane);
                else cumsum_sample_item(it - 2048, inp[4] + (size_t)l * 32 * PAST * 8, LOGF, KBS, lane);
            }
        }
        SEAM(ph + 2);
        STAGE_B_PHASES
    }
#undef IN
#undef SEAM
}

extern "C" void kernel_launch(void* const* d_in, const int* in_sizes, int n_in, void* d_out, int out_size, void* d_ws, size_t ws_size, hipStream_t stream) {
    static int grid = 0;
    if (grid == 0) {
        if (n_in != 25 || (size_t)out_size != O_END || ws_size < WS_END) { fprintf(stderr, "kernel_launch: unexpected shapes (n_in %d out %d ws %zu, need ws %zu)\n", n_in, out_size, ws_size, (size_t)WS_END); grid = -1; return; }
        int dev = 0, cus = 0, per_cu = 0;
        if (hipGetDevice(&dev) != hipSuccess || hipDeviceGetAttribute(&cus, hipDeviceAttributeMultiprocessorCount, dev) != hipSuccess) { grid = -1; return; }
        if (hipFuncSetAttribute((const void*)fwd_kernel, hipFuncAttributeMaxDynamicSharedMemorySize, LDS_BYTES) != hipSuccess) { fprintf(stderr, "kernel_launch: hipFuncSetAttribute failed\n"); grid = -1; return; }
        if (hipOccupancyMaxActiveBlocksPerMultiprocessor(&per_cu, (const void*)fwd_kernel, NWAVES * 64, LDS_BYTES) != hipSuccess || per_cu < 1) { fprintf(stderr, "kernel_launch: occupancy query says %d\n", per_cu); }
        (void)hipGetLastError();
        grid = cus;
    }
    if (grid < 0) return;
    if (hipMemsetAsync((char*)d_ws + WS_CTL, 0, CTL_ZERO_BYTES, stream) != hipSuccess) return;
#if STAGE_ZERO_OUT
    (void)hipMemsetAsync(d_out, 0, (size_t)out_size * 4, stream);
#endif
    Args a{};
    for (int i = 0; i < 25; ++i) a.in[i] = (const float*)d_in[i];
    a.out = (float*)d_out; a.ws = (unsigned char*)d_ws;
#if ONE_LAUNCH
    a.ph_lo = 0; a.ph_hi = N_PHASES;
    hipLaunchKernelGGL(fwd_kernel, dim3(grid), dim3(NWAVES * 64), LDS_BYTES, stream, a);
#else
    for (int p = 0; p < N_PHASES; ++p) { a.ph_lo = p; a.ph_hi = p + 1; hipLaunchKernelGGL(fwd_kernel, dim3(grid), dim3(NWAVES * 64), LDS_BYTES, stream, a); }
#endif
}
```

```cpp
#include <hip/hip_runtime.h>
#include <cstdio>
#include <cstdint>

constexpr int D_MODEL = 2048, DEPTH = 4, N_HEADS = 8, HEAD_DIM = 128, N_GROUPS = 64, STATE_DIM = 64, SSM_GROUP = 16;
constexpr int P_BATCH = 2, P_SEQ = 8192, S_BATCH = 32, S_SEQ = 64, PAST = 1024;
constexpr int MP = P_BATCH * P_SEQ;
constexpr int MS = S_BATCH * S_SEQ;
constexpr int MROWS = MP + MS;
constexpr int D_HALF = 1024, D_PROJ = 6152, N_IN = 6144;
constexpr int NSUB = MROWS / 16;
constexpr float EPS = 1e-6f;
constexpr float SQRT_HD = 11.313708498984761f;

constexpr size_t MiB = 1u << 20;
constexpr size_t WS_CTL = 0, CTL_ZERO_BYTES = 2 * MiB;
constexpr size_t WS_A16  = 2 * MiB;
constexpr size_t WS_WF   = 3 * MiB;
constexpr size_t WS_WIN  = 4 * MiB;
constexpr size_t WS_WGLU = WS_WIN + 4ull * N_IN * 2048 * 2;
constexpr size_t WS_WOUT = WS_WGLU + 4ull * 1024 * 1024 * 2;
constexpr size_t WS_WT   = WS_WOUT + 4ull * 2048 * 2048 * 2;
constexpr size_t WS_BC   = WS_WT + 4ull * 64 * 128 * 256 * 2;
constexpr size_t WS_XB   = WS_BC + 4ull * 64 * 256 * 384 * 2;
constexpr size_t WS_U    = WS_XB + (size_t)MROWS * 2048 * 2;
constexpr size_t WS_SZS  = WS_U + (size_t)MROWS * 1024 * 2;
constexpr size_t WS_Q    = WS_SZS + (size_t)MROWS * 1024 * 2;
constexpr size_t WS_K    = WS_Q + (size_t)MROWS * 1024 * 2;
constexpr size_t WS_V    = WS_K + (size_t)MROWS * 1024 * 2;
constexpr size_t WS_SZA  = WS_V + (size_t)MROWS * 1024 * 2;
constexpr size_t WS_ZS   = WS_SZA + (size_t)MROWS * 1024 * 2;
constexpr size_t WS_YN   = WS_ZS + (size_t)MROWS * 1024 * 2;
constexpr size_t WS_E16  = WS_YN + (size_t)MROWS * 2048 * 2;
constexpr size_t WS_HS   = WS_E16 + (size_t)NSUB * 64 * 128 * 4;
constexpr size_t WS_LOGF = WS_HS + (size_t)NSUB * 64 * 128 * 2;
constexpr size_t WS_KBP  = WS_LOGF + (size_t)MROWS * 8 * 4;
constexpr size_t WS_KBS  = WS_KBP + 16ull * 8192 * 16 * 2;
constexpr size_t WS_END  = WS_KBS + 256ull * 1088 * 16 * 2;
constexpr int CW_BAR = 4096;
constexpr int CW_ROWSQ = 65536;
static_assert((CW_ROWSQ + 5 * MROWS) * 4 <= (int)CTL_ZERO_BYTES, "CTL words inside the memset region");

constexpr size_t O_YP = 0, O_YS = O_YP + (size_t)MP * 2048, O_KP = O_YS + (size_t)MS * 2048, O_VP = O_KP + 4ull * MP * 1024, O_LFP = O_VP + 4ull * MP * 1024,
                 O_HRP = O_LFP + 4ull * MP * 8, O_HIP = O_HRP + 4ull * 2 * 64 * 64, O_KS = O_HIP + 4ull * 2 * 64 * 64, O_VS = O_KS + 4ull * MS * 1024, O_LFS = O_VS + 4ull * MS * 1024,
                 O_HRS = O_LFS + 4ull * MS * 8, O_HIS = O_HRS + 4ull * 32 * 64 * 64, O_END = O_HIS + 4ull * 32 * 64 * 64;
static_assert(O_END == 190447616ull, "output size");

#ifndef N_LAYERS_RUN
#define N_LAYERS_RUN 4
#endif
#define STAGE_ZERO_OUT 0
#ifndef ONE_LAUNCH
#define ONE_LAUNCH 1
#endif
namespace pg8 {
#define PG8_LAS __attribute__((address_space(3)))
typedef unsigned short bf16_t;
typedef short bf16x8 __attribute__((ext_vector_type(8)));
typedef float f32x4 __attribute__((ext_vector_type(4)));
typedef unsigned u32x4 __attribute__((ext_vector_type(4)));
constexpr int BM = 256, BK = 64, HALF = 128, HTB = HALF * BK * 2  , STAGE_BYTES = 8 * HTB, NXCD = 8, WGM = 8;

__host__ __device__ __forceinline__ int lds_byte(int r, int c) { const int st = (r >> 4) * 2 + (c >> 5), rr = r & 15, cc = c & 31, ob = rr * 64 + cc * 2; return st * 1024 + (ob ^ (((ob >> 9) & 1) << 5)); }
__host__ __device__ __forceinline__ void stage_rc(int b, int& R, int& C) { const int st = b / 1024, sb = b % 1024, swz = sb ^ (((sb >> 9) & 1) << 5); R = (st >> 1) * 16 + swz / 64; C = (st & 1) * 32 + (swz % 64) / 2; }
__host__ __device__ __forceinline__ int perm32(int rho) { const int n = rho >> 4, i = rho & 15; return 8 * (i >> 2) + 4 * n + (i & 3); }

struct Unit { int pm, pn; };
struct Gemm { const bf16_t* A; const bf16_t* Bt; int M, N, K; };

struct StaticOrder {
    int nM, nN, nwg, G, c;
    __host__ __device__ void init(int M, int N, int G_, int c_) { nM = M / BM; nN = N / BM; nwg = nM * nN; G = G_; c = c_; }
    __host__ __device__ bool next(int i, Unit& u) const {
        const long L = (long)i * G + c; if (L >= nwg) return false;
        int wgid = (int)L; { const int q = nwg / NXCD, r = nwg % NXCD, xcd = wgid % NXCD, off = wgid / NXCD; wgid = (xcd < r ? xcd * (q + 1) : r * (q + 1) + (xcd - r) * q) + off; }
        const int nig = WGM * nN, gid = wgid / nig, fm = gid * WGM, gsz = (nM - fm) < WGM ? (nM - fm) : WGM;
        u.pm = fm + ((wgid % nig) % gsz); u.pn = (wgid % nig) / gsz; return true;
    }
    __device__ __forceinline__ void a_ready(const Unit&) const {}
    __device__ __forceinline__ void done(const Unit&) const {}
};

__device__ __forceinline__ unsigned cvt_pk_bf16(float lo, float hi) { unsigned r; asm volatile("v_cvt_pk_bf16_f32 %0, %1, %2" : "=v"(r) : "v"(lo), "v"(hi)); return r; }
typedef float f32x2 __attribute__((ext_vector_type(2)));
__device__ __forceinline__ f32x2 gelu_pk(f32x2 v) {
    const f32x2 av = __builtin_elementwise_abs(v), d = av * 0.2316418882f + 1.0f;
    f32x2 t; t.x = __builtin_amdgcn_rcpf(d.x); t.y = __builtin_amdgcn_rcpf(d.y);
    f32x2 q = t * 0.5307027145f + (-0.7265760135f); q = q * t + 0.7107068705f; q = q * t + (-0.142248368f); q = q * t + 0.127414796f; q = q * t;
    const f32x2 s = (v * v) * (-0.72134752044f);
    f32x2 e; e.x = __builtin_amdgcn_exp2f(s.x); e.y = __builtin_amdgcn_exp2f(s.y);
    const f32x2 m = v * (q * e), r = v - m;
    f32x2 o; o.x = v.x < 0.f ? m.x : r.x; o.y = v.y < 0.f ? m.y : r.y; return o;
}

__device__ __forceinline__ float bf_lo(unsigned w) { return __uint_as_float(w << 16); }
__device__ __forceinline__ float bf_hi(unsigned w) { return __uint_as_float(w & 0xffff0000u); }
__device__ __forceinline__ float fast_sigmoid(float v) { return __builtin_amdgcn_rcpf(1.0f + __builtin_amdgcn_exp2f(-1.4426950408889634f * v)); }
__device__ __forceinline__ u32x4 pack8f(const f32x4 a, const f32x4 b) { u32x4 w; w.x = cvt_pk_bf16(a[0], a[1]); w.y = cvt_pk_bf16(a[2], a[3]); w.z = cvt_pk_bf16(b[0], b[1]); w.w = cvt_pk_bf16(b[2], b[3]); return w; }

struct EpiIn {
    static constexpr bool PERM = true, AFTER_DRAIN = false;
    unsigned char* ws; float* out; const float *qg, *kg; int l;
    PG8_LAS float* red;
    __device__ __forceinline__ void operator()(const f32x4 (&acc)[2][2][4][2], const Unit& u, int wr, int wc, int fr, int fq) const {
        const float* rowsq = (const float*)(ws + WS_CTL) + CW_ROWSQ + (size_t)l * MROWS;
        bf16_t* U = (bf16_t*)(ws + WS_U); bf16_t* SZS = (bf16_t*)(ws + WS_SZS); bf16_t* Q = (bf16_t*)(ws + WS_Q); bf16_t* K = (bf16_t*)(ws + WS_K); bf16_t* V = (bf16_t*)(ws + WS_V); bf16_t* SZA = (bf16_t*)(ws + WS_SZA);
        float* kout_p = out + O_KP + (size_t)l * MP * 1024; float* kout_s = out + O_KS + (size_t)l * MS * 1024; float* vout_p = out + O_VP + (size_t)l * MP * 1024; float* vout_s = out + O_VS + (size_t)l * MS * 1024;
        const int region = u.pn >> 2, ct = (u.pn & 3) * 256;
        const int rt = wr * 64 + fr, row0 = u.pm * BM + rt, cw = wc * 32 + 8 * fq;
        float rs[2][4];
#pragma unroll
        for (int ai = 0; ai < 2; ++ai)
#pragma unroll
            for (int m = 0; m < 4; ++m) rs[ai][m] = rsqrtf(rowsq[row0 + ai * HALF + m * 16] * (1.0f / 2048.0f) + EPS);
        if (region == 0) {
#pragma unroll
            for (int ai = 0; ai < 2; ++ai)
#pragma unroll
                for (int m = 0; m < 4; ++m) { const int row = row0 + ai * HALF + m * 16; const float s = rs[ai][m];
#pragma unroll
                    for (int bj = 0; bj < 2; ++bj) { const int col = ct + bj * HALF + cw; const int g = col >> 4, c0 = col & 15;
                        *(u32x4*)(U + ((size_t)g * MROWS + row) * 16 + c0) = pack8f(acc[ai][bj][m][0] * s, acc[ai][bj][m][1] * s); } }
        } else if (region == 1 || region == 5) {
            bf16_t* dst = region == 1 ? SZS : SZA;
#pragma unroll
            for (int ai = 0; ai < 2; ++ai)
#pragma unroll
                for (int m = 0; m < 4; ++m) { const int row = row0 + ai * HALF + m * 16; const float s = rs[ai][m];
#pragma unroll
                    for (int bj = 0; bj < 2; ++bj) { f32x4 a = acc[ai][bj][m][0] * s, b = acc[ai][bj][m][1] * s;
#pragma unroll
                        for (int i = 0; i < 4; ++i) { a[i] = a[i] * fast_sigmoid(a[i]); b[i] = b[i] * fast_sigmoid(b[i]); }
                        *(u32x4*)(dst + (size_t)row * 1024 + ct + bj * HALF + cw) = pack8f(a, b); } }
        } else if (region == 4) {
            float* vo = (u.pm < MP / BM) ? vout_p + (size_t)row0 * 1024 : vout_s + (size_t)(row0 - MP) * 1024;
#pragma unroll
            for (int ai = 0; ai < 2; ++ai)
#pragma unroll
                for (int m = 0; m < 4; ++m) { const int ro = ai * HALF + m * 16; const float s = rs[ai][m];
#pragma unroll
                    for (int bj = 0; bj < 2; ++bj) { const f32x4 a = acc[ai][bj][m][0] * s, b = acc[ai][bj][m][1] * s; const int col = ct + bj * HALF + cw;
                        *(u32x4*)(V + (size_t)(row0 + ro) * 1024 + col) = pack8f(a, b);
                        *(f32x4*)(vo + (size_t)ro * 1024 + col) = a; *(f32x4*)(vo + (size_t)ro * 1024 + col + 4) = b; } }
        } else {
#pragma unroll
            for (int ai = 0; ai < 2; ++ai)
#pragma unroll
                for (int m = 0; m < 4; ++m) { const float s = rs[ai][m];
#pragma unroll
                    for (int bj = 0; bj < 2; ++bj) { const f32x4 a = acc[ai][bj][m][0] * s, b = acc[ai][bj][m][1] * s;
                        float q = (a[0] * a[0] + a[1] * a[1]) + (a[2] * a[2] + a[3] * a[3]) + (b[0] * b[0] + b[1] * b[1]) + (b[2] * b[2] + b[3] * b[3]);
                        q += __shfl_xor(q, 16); q += __shfl_xor(q, 32);
                        if (fq == 0) red[((ai * HALF + wr * 64 + m * 16 + fr) * 2 + bj) * 4 + wc] = q; } }
            asm volatile("s_waitcnt lgkmcnt(0)" ::: "memory"); __builtin_amdgcn_s_barrier(); asm volatile("" ::: "memory");
            const float* gp = (region == 2 ? qg : kg) + cw;
            const f32x4 g0 = *(const f32x4*)gp, g1 = *(const f32x4*)(gp + 4);
            bf16_t* dst = region == 2 ? Q : K;
            float* ko = (u.pm < MP / BM) ? kout_p + (size_t)row0 * 1024 : kout_s + (size_t)(row0 - MP) * 1024;
#pragma unroll
            for (int ai = 0; ai < 2; ++ai)
#pragma unroll
                for (int m = 0; m < 4; ++m) { const int ro = ai * HALF + m * 16;
#pragma unroll
                    for (int bj = 0; bj < 2; ++bj) { const f32x4 t = *(const PG8_LAS f32x4*)(red + ((ai * HALF + wr * 64 + m * 16 + fr) * 2 + bj) * 4);
                        const float sc = rsqrtf(((t[0] + t[1]) + (t[2] + t[3])) * (1.0f / 128.0f) + EPS) * rs[ai][m];
                        const f32x4 a = acc[ai][bj][m][0] * sc * g0, b = acc[ai][bj][m][1] * sc * g1; const int col = ct + bj * HALF + cw;
                        *(u32x4*)(dst + (size_t)(row0 + ro) * 1024 + col) = pack8f(a, b);
                        if (region == 3) { *(f32x4*)(ko + (size_t)ro * 1024 + col) = a; *(f32x4*)(ko + (size_t)ro * 1024 + col + 4) = b; } } }
        }
    }
};

struct EpiGlu {
    static constexpr bool PERM = true, AFTER_DRAIN = false;
    unsigned char* ws; const float* bias;
    __device__ __forceinline__ void operator()(const f32x4 (&acc)[2][2][4][2], const Unit& u, int wr, int wc, int fr, int fq) const {
        const bf16_t* ZS = (const bf16_t*)(ws + WS_ZS); const bf16_t* SZS = (const bf16_t*)(ws + WS_SZS); bf16_t* YN = (bf16_t*)(ws + WS_YN);
        const int row0 = u.pm * BM + wr * 64 + fr, c0 = u.pn * BM + wc * 32 + 8 * fq;
#pragma unroll
        for (int bj = 0; bj < 2; ++bj) { const int col = c0 + bj * HALF; const f32x4 b0 = *(const f32x4*)(bias + col), b1 = *(const f32x4*)(bias + col + 4);
#pragma unroll
            for (int ai = 0; ai < 2; ++ai)
#pragma unroll
                for (int m = 0; m < 4; ++m) { const size_t row = (size_t)(row0 + ai * HALF + m * 16);
                    const u32x4 z = *(const u32x4*)(ZS + row * 1024 + col), s = *(const u32x4*)(SZS + row * 1024 + col);
                    const f32x4 v0 = acc[ai][bj][m][0] + b0, v1 = acc[ai][bj][m][1] + b1; f32x4 o0, o1;
                    o0[0] = bf_lo(z.x) * fast_sigmoid(v0[0]) * bf_lo(s.x); o0[1] = bf_hi(z.x) * fast_sigmoid(v0[1]) * bf_hi(s.x);
                    o0[2] = bf_lo(z.y) * fast_sigmoid(v0[2]) * bf_lo(s.y); o0[3] = bf_hi(z.y) * fast_sigmoid(v0[3]) * bf_hi(s.y);
                    o1[0] = bf_lo(z.z) * fast_sigmoid(v1[0]) * bf_lo(s.z); o1[1] = bf_hi(z.z) * fast_sigmoid(v1[1]) * bf_hi(s.z);
                    o1[2] = bf_lo(z.w) * fast_sigmoid(v1[2]) * bf_lo(s.w); o1[3] = bf_hi(z.w) * fast_sigmoid(v1[3]) * bf_hi(s.w);
                    *(u32x4*)(YN + row * 2048 + col) = pack8f(o0, o1); } }
    }
};

struct EpiOut {
    static constexpr bool PERM = true, AFTER_DRAIN = false;
    const float* xin_p; const float* xin_s; float* xout; unsigned char* ws; int l;
    __device__ __forceinline__ void operator()(const f32x4 (&acc)[2][2][4][2], const Unit& u, int wr, int wc, int fr, int fq) const {
        bf16_t* XB = (bf16_t*)(ws + WS_XB); float* rowsq_next = (float*)(ws + WS_CTL) + CW_ROWSQ + (size_t)(l + 1) * MROWS;
        const int row0 = u.pm * BM + wr * 64 + fr, c0 = u.pn * BM + wc * 32 + 8 * fq;
        const float* xi = (u.pm < MP / BM) ? xin_p + (size_t)row0 * 2048 : xin_s + (size_t)(row0 - MP) * 2048;
#pragma unroll
        for (int ai = 0; ai < 2; ++ai)
#pragma unroll
            for (int m = 0; m < 4; ++m) { const int ro = ai * HALF + m * 16; float ss = 0.f;
#pragma unroll
                for (int bj = 0; bj < 2; ++bj) { const int col = c0 + bj * HALF;
                    const f32x4 a = *(const f32x4*)(xi + (size_t)ro * 2048 + col) + acc[ai][bj][m][0], b = *(const f32x4*)(xi + (size_t)ro * 2048 + col + 4) + acc[ai][bj][m][1];
                    *(f32x4*)(xout + (size_t)(row0 + ro) * 2048 + col) = a; *(f32x4*)(xout + (size_t)(row0 + ro) * 2048 + col + 4) = b;
                    *(u32x4*)(XB + (size_t)(row0 + ro) * 2048 + col) = pack8f(a, b);
                    ss += (a[0] * a[0] + a[1] * a[1]) + (a[2] * a[2] + a[3] * a[3]) + (b[0] * b[0] + b[1] * b[1]) + (b[2] * b[2] + b[3] * b[3]); }
                ss += __shfl_xor(ss, 16); ss += __shfl_xor(ss, 32);
                if (fq == 0) unsafeAtomicAdd(rowsq_next + row0 + ro, ss); }
    }
};
template <class Epi, class Sched, bool ALIGN_EPI = false, bool SP2 = false>
__device__ __forceinline__ void gemm_phase(PG8_LAS unsigned char* lds, const Gemm g, const Sched& S, const Epi& E) {
    int tid_ = threadIdx.x; asm volatile("" : "+v"(tid_));
    const int tid = tid_, wid = __builtin_amdgcn_readfirstlane(tid >> 6), lane = tid & 63, wr = wid >> 2, wc = wid & 3, fr = lane & 15, fq = lane >> 4;
    const int K = g.K, nt = K / BK;
    unsigned voffA[2], voffB[2];
#pragma unroll
    for (int i = 0; i < 2; ++i) { int R, C; stage_rc(tid * 16 + i * 8192, R, C); const int Rb = Epi::PERM ? ((R & ~31) + perm32(R & 31)) : R;
        voffA[i] = (unsigned)(R * K + C) * 2u; voffB[i] = (unsigned)(Rb * K + C) * 2u; }
    const size_t kstep = (size_t)(BK * 2);
    const size_t hstep = (size_t)HALF * K * 2;
    const size_t tstep = 2 * hstep;
    const unsigned ldsw = (unsigned)wid * 1024u;
    const int aoff = lds_byte(wr * 64 + fr, fq * 8), boff = lds_byte(wc * 32 + fr, fq * 8);
#define PG8_SA(b, h) (((b) * 2 + (h)) * HTB)
#define PG8_SB(b, h) ((4 + (b) * 2 + (h)) * HTB)
#define PG8_STAGE(bufoff, gbase, voff) do { _Pragma("unroll") for (int _i = 0; _i < 2; ++_i) \
        __builtin_amdgcn_global_load_lds((const unsigned*)((const char*)(gbase) + (voff)[_i]), (PG8_LAS unsigned*)(lds + (bufoff) + ldsw + _i * 8192), 16, 0, 0); } while (0)
#define PG8_LDA(dst, b, h) do { _Pragma("unroll") for (int m = 0; m < 4; ++m) _Pragma("unroll") for (int k = 0; k < 2; ++k) dst[m][k] = *(const PG8_LAS bf16x8*)(lds + PG8_SA(b, h) + aoff + m * 2048 + k * 1024); } while (0)
#define PG8_LDB(dst, b, h) do { _Pragma("unroll") for (int n = 0; n < 2; ++n) _Pragma("unroll") for (int k = 0; k < 2; ++k) dst[n][k] = *(const PG8_LAS bf16x8*)(lds + PG8_SB(b, h) + boff + n * 2048 + k * 1024); } while (0)
#define PG8_MMA(ai, bj, At, Bt) do { __builtin_amdgcn_s_setprio(1); _Pragma("unroll") for (int m = 0; m < 4; ++m) _Pragma("unroll") for (int n = 0; n < 2; ++n) _Pragma("unroll") for (int k = 0; k < 2; ++k) \
        acc[ai][bj][m][n] = __builtin_amdgcn_mfma_f32_16x16x32_bf16(Bt[n][k], At[m][k], acc[ai][bj][m][n], 0, 0, 0); __builtin_amdgcn_s_setprio(0); } while (0)
#define PG8_WAIT_V(n) asm volatile("s_waitcnt vmcnt(" #n ")" ::: "memory")
#define PG8_WAIT_L(n) asm volatile("s_waitcnt lgkmcnt(" #n ")" ::: "memory")
#define PG8_BAR __builtin_amdgcn_s_barrier()
#define PG8_SCHED __builtin_amdgcn_sched_barrier(0)
    Unit cur, nxt; int ui = 0;
    if (!S.next(0, cur)) return;
    f32x4 acc[2][2][4][2];
#pragma unroll
    for (int a = 0; a < 2; ++a)
#pragma unroll
        for (int b = 0; b < 2; ++b)
#pragma unroll
            for (int m = 0; m < 4; ++m)
#pragma unroll
                for (int n = 0; n < 2; ++n) acc[a][b][m][n] = (f32x4){0.f, 0.f, 0.f, 0.f};
    bf16x8 At[4][2], B0[2][2], B1[2][2];
    const char* cA = (const char*)g.A + (size_t)cur.pm * tstep; const char* cB = (const char*)g.Bt + (size_t)cur.pn * tstep;
    S.a_ready(cur);
    if constexpr (SP2) {
        PG8_STAGE(PG8_SB(0, 0), cB, voffB); PG8_STAGE(PG8_SB(0, 1), cB + hstep, voffB); PG8_STAGE(PG8_SA(0, 0), cA, voffA); PG8_STAGE(PG8_SA(0, 1), cA + hstep, voffA);
        if (wr == 1) PG8_BAR;
        PG8_WAIT_V(2); PG8_BAR;
        PG8_STAGE(PG8_SB(1, 0), cB + kstep, voffB); PG8_STAGE(PG8_SA(1, 0), cA + kstep, voffA); PG8_STAGE(PG8_SB(1, 1), cB + hstep + kstep, voffB);
        PG8_WAIT_V(6); PG8_BAR;
    } else {
        PG8_STAGE(PG8_SB(0, 0), cB, voffB); PG8_STAGE(PG8_SA(0, 0), cA, voffA); PG8_STAGE(PG8_SB(0, 1), cB + hstep, voffB); PG8_STAGE(PG8_SA(0, 1), cA + hstep, voffA);
        if (wr == 1) PG8_BAR;
        PG8_WAIT_V(4); PG8_BAR;
        PG8_STAGE(PG8_SB(1, 0), cB + kstep, voffB); PG8_STAGE(PG8_SA(1, 0), cA + kstep, voffA); PG8_STAGE(PG8_SB(1, 1), cB + hstep + kstep, voffB);
        PG8_WAIT_V(6); PG8_BAR;
    }
    for (;;) {
        const bool has_next = S.next(ui + 1, nxt);
        const char* nA = has_next ? (const char*)g.A + (size_t)nxt.pm * tstep : cA; const char* nB = has_next ? (const char*)g.Bt + (size_t)nxt.pn * tstep : cB;
        for (int t = 0; t < nt; t += 2) {
            const bool last = (t == nt - 2);
            const char* a1 = cA + (size_t)(t + 1) * kstep;
            const char* a2 = last ? nA : cA + (size_t)(t + 2) * kstep; const char* b2 = last ? nB : cB + (size_t)(t + 2) * kstep;
            const char* a3 = a2 + kstep; const char* b3 = b2 + kstep;
            if (last && has_next) S.a_ready(nxt);
            if constexpr (SP2) {
            PG8_LDB(B0, 0, 0); PG8_LDB(B1, 0, 1); PG8_SCHED; PG8_LDA(At, 0, 0); PG8_STAGE(PG8_SA(1, 1), a1 + hstep, voffA);
            PG8_WAIT_V(8); PG8_WAIT_L(0); PG8_BAR; PG8_MMA(0, 0, At, B0); PG8_MMA(0, 1, At, B1); PG8_BAR; PG8_SCHED;
            PG8_LDA(At, 0, 1); PG8_STAGE(PG8_SB(0, 0), b2, voffB); PG8_STAGE(PG8_SB(0, 1), b2 + hstep, voffB); PG8_STAGE(PG8_SA(0, 0), a2, voffA);
            PG8_WAIT_V(8); PG8_WAIT_L(0); PG8_BAR; PG8_MMA(1, 0, At, B0); PG8_MMA(1, 1, At, B1); PG8_BAR; PG8_SCHED;
            PG8_LDB(B0, 1, 0); PG8_LDB(B1, 1, 1); PG8_SCHED; PG8_LDA(At, 1, 0); PG8_STAGE(PG8_SA(0, 1), a2 + hstep, voffA);
            PG8_WAIT_V(8); PG8_WAIT_L(0); PG8_BAR; PG8_MMA(0, 0, At, B0); PG8_MMA(0, 1, At, B1); PG8_BAR; PG8_SCHED;
            PG8_LDA(At, 1, 1); PG8_STAGE(PG8_SB(1, 0), b3, voffB); PG8_STAGE(PG8_SB(1, 1), b3 + hstep, voffB); PG8_STAGE(PG8_SA(1, 0), a3, voffA);
            PG8_WAIT_V(8); PG8_WAIT_L(0); PG8_BAR; PG8_MMA(1, 0, At, B0); PG8_MMA(1, 1, At, B1); PG8_BAR; PG8_SCHED;
            } else {
            PG8_LDB(B0, 0, 0); PG8_SCHED; PG8_LDA(At, 0, 0); PG8_STAGE(PG8_SA(1, 1), a1 + hstep, voffA);
            PG8_WAIT_L(8); PG8_BAR; PG8_WAIT_L(0); PG8_MMA(0, 0, At, B0); PG8_BAR; PG8_SCHED;
            PG8_LDB(B1, 0, 1); PG8_STAGE(PG8_SB(0, 0), b2, voffB);
            PG8_BAR; PG8_WAIT_L(0); PG8_MMA(0, 1, At, B1); PG8_BAR;
            PG8_LDA(At, 0, 1); PG8_STAGE(PG8_SA(0, 0), a2, voffA);
            PG8_BAR; PG8_WAIT_L(0); PG8_MMA(1, 0, At, B0); PG8_BAR; PG8_SCHED;
            PG8_STAGE(PG8_SB(0, 1), b2 + hstep, voffB);
            PG8_WAIT_V(6); PG8_BAR; PG8_MMA(1, 1, At, B1); PG8_BAR;
            PG8_LDB(B0, 1, 0); PG8_SCHED; PG8_LDA(At, 1, 0); PG8_STAGE(PG8_SA(0, 1), a2 + hstep, voffA);
            PG8_WAIT_L(8); PG8_BAR; PG8_WAIT_L(0); PG8_MMA(0, 0, At, B0); PG8_BAR; PG8_SCHED;
            PG8_LDB(B1, 1, 1); PG8_STAGE(PG8_SB(1, 0), b3, voffB);
            PG8_BAR; PG8_WAIT_L(0); PG8_MMA(0, 1, At, B1); PG8_BAR;
            PG8_LDA(At, 1, 1); PG8_STAGE(PG8_SA(1, 0), a3, voffA);
            PG8_BAR; PG8_WAIT_L(0); PG8_MMA(1, 0, At, B0); PG8_BAR; PG8_SCHED;
            PG8_STAGE(PG8_SB(1, 1), b3 + hstep, voffB);
            PG8_WAIT_V(6); PG8_BAR; PG8_MMA(1, 1, At, B1); PG8_BAR;
            }
        }
        if constexpr (ALIGN_EPI) { if (wr == 0) PG8_BAR; }
        if constexpr (!Epi::AFTER_DRAIN) { E(acc, cur, wr, wc, fr, fq); S.done(cur); }
        if (!has_next) break;
#pragma unroll
        for (int a = 0; a < 2; ++a)
#pragma unroll
            for (int b = 0; b < 2; ++b)
#pragma unroll
                for (int m = 0; m < 4; ++m)
#pragma unroll
                    for (int n = 0; n < 2; ++n) acc[a][b][m][n] = (f32x4){0.f, 0.f, 0.f, 0.f};
        cur = nxt; cA = nA; cB = nB; ++ui;
        if constexpr (ALIGN_EPI) { if (wr == 1) PG8_BAR; }
    }
    PG8_WAIT_V(0);
    if constexpr (!ALIGN_EPI) { if (wr == 0) PG8_BAR; }
    PG8_BAR;
    if constexpr (Epi::AFTER_DRAIN) { E.fused(acc, cur, wr, wc, fr, fq, lds, wid, lane); S.done(cur); }
#undef PG8_SA
#undef PG8_SB
#undef PG8_STAGE
#undef PG8_LDA
#undef PG8_LDB
#undef PG8_MMA
#undef PG8_WAIT_V
#undef PG8_WAIT_L
#undef PG8_BAR
#undef PG8_SCHED
}
}

constexpr int RING_OFF = 0, RING_BYTES = 131072;
constexpr int RED_OFF = RING_BYTES;
constexpr int MISC_OFF = RED_OFF + 8192;
constexpr int LDS_BYTES = 147456;
static_assert(MISC_OFF + 128 <= LDS_BYTES, "LDS map");
constexpr int NWAVES = 8;

#define GAS __attribute__((address_space(1)))
#define LAS __attribute__((address_space(3)))
typedef unsigned short bf16;
typedef unsigned v4u __attribute__((ext_vector_type(4)));
typedef unsigned v2u __attribute__((ext_vector_type(2)));
typedef float f32x4 __attribute__((ext_vector_type(4)));
typedef float f32x16 __attribute__((ext_vector_type(16)));
typedef short bf16x8 __attribute__((ext_vector_type(8)));
#define LDS_WAIT() asm volatile("s_waitcnt lgkmcnt(0)" ::: "memory")
#define VM_WAIT() asm volatile("s_waitcnt vmcnt(0)" ::: "memory")
__device__ __forceinline__ unsigned f2bf(float f) { unsigned u = __builtin_bit_cast(unsigned, f); return (u + 0x7fffu + ((u >> 16) & 1u)) >> 16; }
__device__ __forceinline__ unsigned pk2(float lo, float hi) { return f2bf(lo) | (f2bf(hi) << 16); }
__device__ __forceinline__ float bf2f(unsigned h) { return __uint_as_float(h << 16); }
__device__ __forceinline__ float wave_sum(float v) {
#pragma unroll
    for (int o = 1; o < 64; o <<= 1) v += __shfl_xor(v, o);
    return v;
}
#define XB_TMO      128
#define XB_XCNT(j)  (256  + 64 * (j))
#define XB_XSUB(j)  (1280 + 64 * (j))
#define XB_XGEN(j)  (2304 + 64 * (j))
#define XB_TOP      3328
#define XB_TOPGEN   3392
#define XCD_BAR_WORDS 3456
#define XB_SPIN_CAP (1u << 18)

__device__ __forceinline__ unsigned xb_ld(unsigned* p)              { return __hip_atomic_load(p, __ATOMIC_RELAXED, __HIP_MEMORY_SCOPE_AGENT); }
__device__ __forceinline__ unsigned xb_add(unsigned* p, unsigned v) { return __hip_atomic_fetch_add(p, v, __ATOMIC_RELAXED, __HIP_MEMORY_SCOPE_AGENT); }
__device__ __forceinline__ unsigned xb_xcc_id() { return (unsigned)__builtin_amdgcn_s_getreg((3 << 11) | 20) & 0xFu; }
#define XB_SPIN(cond, bar) do { unsigned _sp = 0; while (cond) { __builtin_amdgcn_s_sleep(1); \
    if ((++_sp & 255u) == 0u) { if (xb_ld(&(bar)[XB_TMO])) break; if (_sp > XB_SPIN_CAP) { atomicAdd(&(bar)[XB_TMO], 1u); break; } } } } while (0)

struct XcdBarrier {
    unsigned* bar; unsigned x;
    volatile LAS unsigned* st;
};

__device__ __forceinline__ XcdBarrier xcd_barrier_post(unsigned* bar, volatile LAS unsigned* st) {
    XcdBarrier b; b.bar = bar; b.x = xb_xcc_id(); b.st = st;
    if (threadIdx.x == 0) (void)xb_add(&bar[XB_XCNT(b.x)], 1u);
    return b;
}
__device__ __forceinline__ void xcd_barrier_complete(unsigned* bar, unsigned x, unsigned& nloc, unsigned& nx) {
    const unsigned G = gridDim.x * gridDim.y * gridDim.z;
    unsigned sum, cnt, mine, sp = 0u;
    for (;;) {
        sum = 0u; cnt = 0u; mine = 0u;
#pragma unroll
        for (unsigned j = 0; j < 16; ++j) { const unsigned c = xb_ld(&bar[XB_XCNT(j)]); sum += c; cnt += (c > 0u) ? 1u : 0u; mine = (j == x) ? c : mine; }
        if (sum == G) break;
        __builtin_amdgcn_s_sleep(1);
        if ((++sp & 255u) == 0u) { if (xb_ld(&bar[XB_TMO])) break; if (sp > XB_SPIN_CAP) { atomicAdd(&bar[XB_TMO], 1u); break; } }
    }
    nloc = mine > 0u ? mine : 1u; nx = cnt > 0u ? cnt : 1u;
}

__device__ __forceinline__ void xcd_barrier(const XcdBarrier& b) {
    asm volatile("s_waitcnt vmcnt(0)" ::: "memory");
    __syncthreads();
    if (threadIdx.x == 0) {
        unsigned* bar = b.bar;
        __builtin_amdgcn_s_waitcnt(0);
        unsigned nloc = b.st[0], nx = b.st[1];
        if (nloc == 0u) { xcd_barrier_complete(bar, b.x, nloc, nx); b.st[0] = nloc; b.st[1] = nx; }
        const unsigned old = xb_add(&bar[XB_XSUB(b.x)], 1u);
        const unsigned gen = old / nloc;
        if (old + 1u == (gen + 1u) * nloc) {
            __builtin_amdgcn_fence(__ATOMIC_RELEASE, "agent");
            asm volatile("s_waitcnt vmcnt(0)" ::: "memory");
            const unsigned og = xb_add(&bar[XB_TOP], 1u);
            const unsigned tg = og / nx;
            if (og + 1u == (tg + 1u) * nx) xb_add(&bar[XB_TOPGEN], 1u);
            else XB_SPIN(xb_ld(&bar[XB_TOPGEN]) == tg, bar);
            __builtin_amdgcn_fence(__ATOMIC_ACQUIRE, "agent");
            xb_add(&bar[XB_XGEN(b.x)], 1u);
            asm volatile("s_waitcnt vmcnt(0)" ::: "memory");
        } else {
            XB_SPIN(xb_ld(&bar[XB_XGEN(b.x)]) == gen, bar);
            __builtin_amdgcn_fence(__ATOMIC_ACQUIRE, "agent");
            asm volatile("s_waitcnt vmcnt(0)" ::: "memory");
        }
    }
    __syncthreads();
}

__device__ __forceinline__ int crow(int r, int hi) { return (r & 3) + 8 * (r >> 2) + 4 * hi; }
#define MFMA32(a, b, c) __builtin_amdgcn_mfma_f32_32x32x16_bf16((a), (b), (c), 0, 0, 0)
#define MFMA16(a, b, c) __builtin_amdgcn_mfma_f32_16x16x32_bf16((a), (b), (c), 0, 0, 0)

__device__ __forceinline__ void dsincos(double x, double& s, double& c) {
    const double k = __builtin_rint(x * 0.63661977236758134308);
    double r = __builtin_fma(-k, 1.57079632679489655800e+00, x); r = __builtin_fma(-k, 6.12323399573676603587e-17, r);
    const double r2 = r * r;
    double sp = -7.6471637318198164759e-13;
    sp = sp * r2 + 1.6059043836821614599e-10; sp = sp * r2 - 2.5052108385441718775e-08; sp = sp * r2 + 2.7557319223985890653e-06;
    sp = sp * r2 - 1.9841269841269841270e-04; sp = sp * r2 + 8.3333333333333333333e-03; sp = sp * r2 - 1.6666666666666666667e-01;
    const double sr = r + r * r2 * sp;
    double cp = 4.7794773323873852974e-14;
    cp = cp * r2 - 1.1470745597729724714e-11; cp = cp * r2 + 2.0876756987868098979e-09; cp = cp * r2 - 2.7557319223985890653e-07;
    cp = cp * r2 + 2.4801587301587301587e-05; cp = cp * r2 - 1.3888888888888888889e-03; cp = cp * r2 + 4.1666666666666666667e-02; cp = cp * r2 - 0.5;
    const double cr = 1.0 + r2 * cp;
    const int q = ((int)k) & 3;
    s = (q == 0) ? sr : (q == 1) ? cr : (q == 2) ? -sr : -cr;
    c = (q == 0) ? cr : (q == 1) ? -sr : (q == 2) ? -cr : sr;
}

__device__ __forceinline__ void p0_transpose_item(const float* W, int ldw, int K, bf16* WT, const float* gain, LAS float* scr, int kb, int nb, int lane) {
    const int k0 = 64 * kb, n0 = 32 * nb;
#pragma unroll 8
    for (int i = 0; i < 32; ++i) { const int kk = 2 * i + (lane >> 5); float v = W[(size_t)(k0 + kk) * ldw + n0 + (lane & 31)]; if (gain) v *= gain[k0 + kk]; scr[kk * 33 + (lane & 31)] = v; }
    LDS_WAIT(); asm volatile("" ::: "memory");
    const int c = lane & 7;
#pragma unroll
    for (int j = 0; j < 4; ++j) { const int n = (lane >> 3) + 8 * j; const LAS float* s = scr + (8 * c) * 33 + n;
        v4u o; o.x = pk2(s[0 * 33], s[1 * 33]); o.y = pk2(s[2 * 33], s[3 * 33]); o.z = pk2(s[4 * 33], s[5 * 33]); o.w = pk2(s[6 * 33], s[7 * 33]);
        *(GAS v4u*)(WT + (size_t)(n0 + n) * K + k0 + 8 * c) = o; }
    LDS_WAIT(); asm volatile("" ::: "memory");
}

__device__ __forceinline__ void p0_s5_item(int l, int g, const float* const* in, bf16* WT, bf16* BC, float* A16, LAS float* scr, int tid) {
    LAS float* PWR = scr; LAS float* PWI = scr + 1088; LAS float* BPR = scr + 2176; LAS float* BPI = scr + 3200;
    LAS float* CR = scr + 4224; LAS float* CI = scr + 5248; LAS float* KL = scr + 6272; LAS float* DD = scr + 10368;
    const int lg = l * 64 + g;
    if (tid < 64) {
        const int p = tid;
        const double dt = exp((double)in[12][lg]);
        const double ar = (double)in[13][lg * 64 + p], ai = (double)in[14][lg * 64 + p];
        const double mag = exp(ar * dt); double sn, cs; dsincos(ai * dt, sn, cs);
        const double abr = mag * cs, abi = mag * sn;
        const double den = ar * ar + ai * ai, nr = abr - 1.0, ni = abi;
        const double cfr = (nr * ar + ni * ai) / den, cfi = (ni * ar - nr * ai) / den;
        double pr = 1.0, pi = 0.0;
        for (int n = 0; n <= 16; ++n) { PWR[n * 64 + p] = (float)pr; PWI[n * 64 + p] = (float)pi; const double t = pr * abr - pi * abi; pi = pr * abi + pi * abr; pr = t; }
        A16[(g * 64 + p) * 2] = PWR[16 * 64 + p]; A16[(g * 64 + p) * 2 + 1] = PWI[16 * 64 + p];
        const float* br = in[15] + ((size_t)lg * 64 + p) * 16; const float* bi = in[16] + ((size_t)lg * 64 + p) * 16;
        for (int c = 0; c < 16; ++c) { const double x = br[c], y = bi[c]; BPR[p * 16 + c] = (float)(cfr * x - cfi * y); BPI[p * 16 + c] = (float)(cfr * y + cfi * x); }
    } else {
        for (int i = tid - 64; i < 1024; i += 448) { CR[i] = in[17][(size_t)lg * 1024 + i]; CI[i] = in[18][(size_t)lg * 1024 + i]; }
        if (tid < 80) DD[tid - 64] = in[19][lg * 16 + tid - 64];
    }
    __syncthreads();
    for (int o = tid; o < 4096; o += 512) { const int lag = o >> 8, c = (o >> 4) & 15, cp = o & 15; float a = 0.f;
        for (int p = 0; p < 64; ++p) { const float pr = PWR[lag * 64 + p], pi = PWI[lag * 64 + p], br = BPR[p * 16 + cp], bi = BPI[p * 16 + cp];
            a += CR[c * 64 + p] * (pr * br - pi * bi) - CI[c * 64 + p] * (pr * bi + pi * br); }
        if (lag == 0 && c == cp) a += DD[c];
        KL[o] = a; }
    __syncthreads();
    bf16* bc = BC + (size_t)g * 256 * 384;
    for (int q = tid; q < 12288; q += 512) { const int n = q / 48, k0 = (q % 48) * 8, t = n >> 4, c = n & 15; float v[8];
        if (k0 < 256) { const int s = k0 >> 4, cp0 = k0 & 15;
#pragma unroll
            for (int e = 0; e < 8; ++e) v[e] = (s <= t) ? KL[(t - s) * 256 + c * 16 + cp0 + e] : 0.f;
        } else { const int kk0 = k0 - 256; const bool im = kk0 >= 64; const int p0 = im ? kk0 - 64 : kk0;
#pragma unroll
            for (int e = 0; e < 8; ++e) { const int p = p0 + e; const float cr = CR[c * 64 + p], ci = CI[c * 64 + p], pr = PWR[(t + 1) * 64 + p], pi = PWI[(t + 1) * 64 + p];
                v[e] = im ? -(cr * pi + ci * pr) : (cr * pr - ci * pi); } }
        v4u o; o.x = pk2(v[0], v[1]); o.y = pk2(v[2], v[3]); o.z = pk2(v[4], v[5]); o.w = pk2(v[6], v[7]);
        *(GAS v4u*)(bc + (size_t)n * 384 + k0) = o; }
    bf16* wt = WT + (size_t)g * 128 * 256;
    for (int q = tid; q < 4096; q += 512) { const int n = q >> 5, k0 = (q & 31) * 8, s = k0 >> 4, cp0 = k0 & 15, p = n & 63; const bool im = n >= 64; float v[8];
        const float pr = PWR[(15 - s) * 64 + p], pi = PWI[(15 - s) * 64 + p];
#pragma unroll
        for (int e = 0; e < 8; ++e) { const float br = BPR[p * 16 + cp0 + e], bi = BPI[p * 16 + cp0 + e]; v[e] = im ? (pr * bi + pi * br) : (pr * br - pi * bi); }
        v4u o; o.x = pk2(v[0], v[1]); o.y = pk2(v[2], v[3]); o.z = pk2(v[4], v[5]); o.w = pk2(v[6], v[7]);
        *(GAS v4u*)(wt + (size_t)n * 256 + k0) = o; }
    __syncthreads();
}

__device__ __forceinline__ void p0_row_item(const float* xrow, bf16* orow, float* rsq, int lane) {
    const GAS f32x4* xr = (const GAS f32x4*)xrow + lane; GAS v2u* o8 = (GAS v2u*)orow + lane; float s = 0.f;
#pragma unroll
    for (int j = 0; j < 8; ++j) { const f32x4 v = xr[64 * j]; s += (v[0] * v[0] + v[1] * v[1]) + (v[2] * v[2] + v[3] * v[3]); v2u w; w.x = pk2(v[0], v[1]); w.y = pk2(v[2], v[3]); o8[64 * j] = w; }
    s = wave_sum(s);
    if (lane == 0) *rsq = s;
}

__device__ __forceinline__ void p0_prologue(const float* const* in, unsigned char* ws, LAS unsigned char* lds, int tid, int wave, int lane, int vcu, int G) {
    for (int it = vcu; it < DEPTH * 64; it += G) { const int l = it >> 6, g = it & 63;
        p0_s5_item(l, g, in, (bf16*)(ws + WS_WT) + (size_t)l * 64 * 128 * 256, (bf16*)(ws + WS_BC) + (size_t)l * 64 * 256 * 384, (float*)(ws + WS_A16) + (size_t)l * 64 * 64 * 2, (LAS float*)(lds + RING_OFF), tid); }
    LAS float* scr = (LAS float*)(lds + RING_OFF + wave * 16384);
    const int gw = vcu * NWAVES + wave, NGW = G * NWAVES;
    constexpr int I_IN = 32 * 192, I_GLU = 16 * 32, I_OUT = 32 * 64, PER_L = I_IN + I_GLU + I_OUT;
    for (int it = gw; it < DEPTH * PER_L; it += NGW) { const int l = it / PER_L; int r = it - l * PER_L;
        if (r < I_IN) { p0_transpose_item(in[8] + (size_t)l * 2048 * D_PROJ, D_PROJ, 2048, (bf16*)(ws + WS_WIN) + (size_t)l * N_IN * 2048, in[7] + l * 2048, scr, r / 192, r % 192, lane); continue; } r -= I_IN;
        if (r < I_GLU) { p0_transpose_item(in[20] + (size_t)l * 1024 * 1024, 1024, 1024, (bf16*)(ws + WS_WGLU) + (size_t)l * 1024 * 1024, nullptr, scr, r / 32, r % 32, lane); continue; } r -= I_GLU;
        { const int kb = r / 64; const float* gn = (kb < 16) ? in[22] + l * 1024 : in[23] + l * 1024 - 1024;
          p0_transpose_item(in[24] + (size_t)l * 2048 * 2048, 2048, 2048, (bf16*)(ws + WS_WOUT) + (size_t)l * 2048 * 2048, gn, scr, kb, r % 64, lane); } }
    for (int it = gw; it < DEPTH * 16; it += NGW) { const int l = it >> 4, h = it & 15; bf16* wf = (bf16*)(ws + WS_WF) + (size_t)it * 2048;
        for (int k = lane; k < 2048; k += 64) { const float v = (h < 8) ? in[7][l * 2048 + k] * in[8][((size_t)l * 2048 + k) * D_PROJ + N_IN + h] : 0.f; wf[k] = (bf16)f2bf(v); } }
    float* rowsq0 = (float*)(ws + WS_CTL) + CW_ROWSQ;
    for (int m = gw; m < MROWS; m += NGW) { const float* xr = (m < MP) ? in[0] + (size_t)m * 2048 : in[1] + (size_t)(m - MP) * 2048;
        p0_row_item(xr, (bf16*)(ws + WS_XB) + (size_t)m * 2048, rowsq0 + m, lane); }
}

__device__ __forceinline__ float log_sigmoid(float x) { return (x >= 0.f) ? -log1pf(expf(-x)) : x - log1pf(expf(x)); }

__device__ __forceinline__ void fpre_item(int item, const bf16* XB, const bf16* WF, const float* rowsq, const float* bfv, float* LOGF, float* out_p, float* out_s, int lane) {
    const int row0 = item * 16, fr = lane & 15, fq = lane >> 4;
    const bf16* a = XB + (size_t)(row0 + fr) * 2048 + 8 * fq; const bf16* b = WF + (size_t)fr * 2048 + 8 * fq;
    f32x4 acc = {0.f, 0.f, 0.f, 0.f};
#pragma unroll 8
    for (int kk = 0; kk < 64; ++kk) { const bf16x8 av = *(const bf16x8*)(a + kk * 32), bv = *(const bf16x8*)(b + kk * 32); acc = MFMA16(av, bv, acc); }
    if (fr < 8) {
#pragma unroll
        for (int i = 0; i < 4; ++i) { const int row = row0 + 4 * fq + i; const float rs = rsqrtf(rowsq[row] * (1.0f / 2048.0f) + EPS);
            const float lf = log_sigmoid(acc[i] * rs + bfv[fr]); LOGF[row * 8 + fr] = lf;
            if (row < MP) out_p[row * 8 + fr] = lf; else out_s[(row - MP) * 8 + fr] = lf; } }
}

__device__ __forceinline__ void e16_item(int item, const bf16* U, const bf16* WT, float* E16, int lane) {
    const int nh = item & 1, t2 = item >> 1, jb = t2 % 36, g = t2 / 36, r32 = lane & 31, hi = lane >> 5;
    const bf16* bp = U + ((size_t)g * MROWS + (size_t)(jb * 32 + r32) * 16) * 16 + 8 * hi;
    const bf16* ap = WT + ((size_t)(g * 128 + nh * 64 + r32)) * 256 + 8 * hi;
    f32x16 acc0 = {}, acc1 = {};
#pragma unroll 4
    for (int s = 0; s < 16; ++s) { const bf16x8 b = *(const bf16x8*)(bp + 16 * s); const bf16x8 a0 = *(const bf16x8*)(ap + 16 * s), a1 = *(const bf16x8*)(ap + 32 * 256 + 16 * s);
        acc0 = MFMA32(a0, b, acc0); acc1 = MFMA32(a1, b, acc1); }
    float* ep = E16 + ((size_t)(jb * 32 + r32) * 64 + g) * 128 + nh * 64 + 4 * hi;
#pragma unroll
    for (int rq = 0; rq < 4; ++rq) { *(f32x4*)(ep + 8 * rq) = (f32x4){acc0[4 * rq], acc0[4 * rq + 1], acc0[4 * rq + 2], acc0[4 * rq + 3]};
        *(f32x4*)(ep + 32 + 8 * rq) = (f32x4){acc1[4 * rq], acc1[4 * rq + 1], acc1[4 * rq + 2], acc1[4 * rq + 3]}; }
}

__device__ __forceinline__ void carry_prompt_item(int item, const float* E16, const float* A16, bf16* HS, float* out_re, float* out_im, LAS float* scr, int wave, int lane) {
    const int b = item >> 6, g = item & 63, p = lane;
    const float ar = A16[(g * 64 + p) * 2], ai = A16[(g * 64 + p) * 2 + 1];
    const int j0 = b * 512 + wave * 64;
    const float* ep = E16 + ((size_t)j0 * 64 + g) * 128 + p;
    float hr = 0.f, hm = 0.f;
#pragma unroll 1
    for (int jb = 0; jb < 2; ++jb) { float er[32], ei[32];
#pragma unroll
        for (int j = 0; j < 32; ++j) { er[j] = ep[(size_t)(jb * 32 + j) * 8192]; ei[j] = ep[(size_t)(jb * 32 + j) * 8192 + 64]; }
#pragma unroll
        for (int j = 0; j < 32; ++j) { const float nr = ar * hr - ai * hm + er[j], ni = ar * hm + ai * hr + ei[j]; hr = nr; hm = ni; } }
    scr[(wave * 64 + p) * 2] = hr; scr[(wave * 64 + p) * 2 + 1] = hm;
    float sr = ar, si = ai;
#pragma unroll
    for (int q = 0; q < 6; ++q) { const float t = sr * sr - si * si; si = 2.f * sr * si; sr = t; }
    LDS_WAIT(); __syncthreads();
    float cr = 0.f, ci = 0.f;
    for (int v = 0; v < wave; ++v) { const float xr = scr[(v * 64 + p) * 2], xi = scr[(v * 64 + p) * 2 + 1]; const float nr = sr * cr - si * ci + xr, ni = sr * ci + si * cr + xi; cr = nr; ci = ni; }
    bf16* hp = HS + ((size_t)j0 * 64 + g) * 128 + p;
    hr = cr; hm = ci; asm volatile("" ::: "memory");
#pragma unroll 1
    for (int jb = 0; jb < 2; ++jb) { float er[32], ei[32];
#pragma unroll
        for (int j = 0; j < 32; ++j) { er[j] = ep[(size_t)(jb * 32 + j) * 8192]; ei[j] = ep[(size_t)(jb * 32 + j) * 8192 + 64]; }
#pragma unroll
        for (int j = 0; j < 32; ++j) { hp[(size_t)(jb * 32 + j) * 8192] = (bf16)f2bf(hr); hp[(size_t)(jb * 32 + j) * 8192 + 64] = (bf16)f2bf(hm);
            const float nr = ar * hr - ai * hm + er[j], ni = ar * hm + ai * hr + ei[j]; hr = nr; hm = ni; } }
    if (wave == 7) { out_re[(b * 64 + g) * 64 + p] = hr; out_im[(b * 64 + g) * 64 + p] = hm; }
    __syncthreads();
}
__device__ __forceinline__ void carry_sample_item(int item, const float* E16, const float* A16, const float* h0r, const float* h0i, bf16* HS, float* out_re, float* out_im, int lane) {
    const int b = item >> 6, g = item & 63, p = lane;
    const float ar = A16[(g * 64 + p) * 2], ai = A16[(g * 64 + p) * 2 + 1];
    const int j0 = MP / 16 + b * 4;
    const float* ep = E16 + ((size_t)j0 * 64 + g) * 128 + p; bf16* hp = HS + ((size_t)j0 * 64 + g) * 128 + p;
    float hr = h0r[(b * 64 + g) * 64 + p], hm = h0i[(b * 64 + g) * 64 + p];
#pragma unroll
    for (int j = 0; j < 4; ++j) { hp[(size_t)j * 8192] = (bf16)f2bf(hr); hp[(size_t)j * 8192 + 64] = (bf16)f2bf(hm);
        const float xr = ep[(size_t)j * 8192], xi = ep[(size_t)j * 8192 + 64]; const float nr = ar * hr - ai * hm + xr, ni = ar * hm + ai * hr + xi; hr = nr; hm = ni; }
    out_re[(b * 64 + g) * 64 + p] = hr; out_im[(b * 64 + g) * 64 + p] = hm;
}

__device__ __forceinline__ void store_kb(bf16* kp, float c) {
    const float val = -c * SQRT_HD; const unsigned h0 = f2bf(val); const float r1 = val - bf2f(h0); const unsigned h1 = f2bf(r1); const float r2 = r1 - bf2f(h1); const unsigned h2 = f2bf(r2);
    v4u a; a.x = h0 | (h1 << 16); a.y = h2; a.z = 0u; a.w = 0u; v4u z = {0u, 0u, 0u, 0u};
    *(GAS v4u*)kp = a; *(GAS v4u*)(kp + 8) = z;
}
__device__ __forceinline__ void cumsum_prompt_item(int item, const float* LOGF, bf16* KBP, LAS float* scr, int tid, int wave, int lane) {
    const int b = item >> 3, h = item & 7;
    const float* lp = LOGF + ((size_t)(b * P_SEQ + tid * 16)) * 8 + h;
    float v[16];
#pragma unroll
    for (int i = 0; i < 16; ++i) v[i] = lp[i * 8];
    float run = 0.f;
#pragma unroll
    for (int i = 0; i < 16; ++i) { run += v[i]; v[i] = run; }
    float x = run;
#pragma unroll
    for (int o = 1; o < 64; o <<= 1) { const float y = __shfl_up(x, o); if (lane >= o) x += y; }
    if (lane == 63) scr[wave] = x;
    LDS_WAIT(); __syncthreads();
    float base = x - run;
    for (int w = 0; w < wave; ++w) base += scr[w];
    bf16* kp = KBP + ((size_t)item * P_SEQ + tid * 16) * 16;
#pragma unroll
    for (int i = 0; i < 16; ++i) store_kb(kp + i * 16, base + v[i]);
    __syncthreads();
}
__device__ __forceinline__ void cumsum_sample_item(int item, const float* cache_logf  , const float* LOGF, bf16* KBS, int lane) {
    const int b = item >> 3, h = item & 7;
    float v[17]; float run = 0.f;
#pragma unroll
    for (int i = 0; i < 17; ++i) { const int s = lane * 17 + i; const float x = (s < PAST) ? cache_logf[((size_t)b * PAST + s) * 8 + h] : LOGF[((size_t)(MP + b * S_SEQ + s - PAST)) * 8 + h]; run += x; v[i] = run; }
    float x = run;
#pragma unroll
    for (int o = 1; o < 64; o <<= 1) { const float y = __shfl_up(x, o); if (lane >= o) x += y; }
    const float base = x - run;
    bf16* kp = KBS + ((size_t)item * (PAST + S_SEQ) + lane * 17) * 16;
#pragma unroll
    for (int i = 0; i < 17; ++i) store_kb(kp + i * 16, base + v[i]);
}

__device__ __forceinline__ void sc_item(int item, const bf16* U, const bf16* HS, const bf16* BC, bf16* ZS, int lane) {
    const int nq = item & 1, t2 = item >> 1, jb = t2 % 36, g = t2 / 36, r32 = lane & 31, hi = lane >> 5, j = jb * 32 + r32;
    const bf16* bu = U + ((size_t)g * MROWS + (size_t)j * 16) * 16 + 8 * hi;
    const bf16* bh = HS + ((size_t)j * 64 + g) * 128 + 8 * hi;
    const bf16* ap = BC + ((size_t)(g * 256 + nq * 128 + r32)) * 384 + 8 * hi;
    f32x16 acc0 = {}, acc1 = {}, acc2 = {}, acc3 = {};
#pragma unroll 4
    for (int s = 0; s < 16; ++s) { const bf16x8 b = *(const bf16x8*)(bu + 16 * s);
        const bf16x8 a0 = *(const bf16x8*)(ap + 16 * s), a1 = *(const bf16x8*)(ap + 32 * 384 + 16 * s), a2 = *(const bf16x8*)(ap + 64 * 384 + 16 * s), a3 = *(const bf16x8*)(ap + 96 * 384 + 16 * s);
        acc0 = MFMA32(a0, b, acc0); acc1 = MFMA32(a1, b, acc1); acc2 = MFMA32(a2, b, acc2); acc3 = MFMA32(a3, b, acc3); }
#pragma unroll 4
    for (int s = 0; s < 8; ++s) { const bf16x8 b = *(const bf16x8*)(bh + 16 * s); const bf16* aq = ap + 256 + 16 * s;
        const bf16x8 a0 = *(const bf16x8*)(aq), a1 = *(const bf16x8*)(aq + 32 * 384), a2 = *(const bf16x8*)(aq + 64 * 384), a3 = *(const bf16x8*)(aq + 96 * 384);
        acc0 = MFMA32(a0, b, acc0); acc1 = MFMA32(a1, b, acc1); acc2 = MFMA32(a2, b, acc2); acc3 = MFMA32(a3, b, acc3); }
#define SC_STORE(ACC, nb) do { _Pragma("unroll") for (int rq = 0; rq < 4; ++rq) { const int n0 = nq * 128 + (nb) * 32 + 8 * rq + 4 * hi; const int t = n0 >> 4, c0 = n0 & 15; \
        const pg8::f32x2 ga = pg8::gelu_pk((pg8::f32x2){ACC[4 * rq], ACC[4 * rq + 1]}), gb = pg8::gelu_pk((pg8::f32x2){ACC[4 * rq + 2], ACC[4 * rq + 3]}); \
        v2u w; w.x = pg8::cvt_pk_bf16(ga.x, ga.y); w.y = pg8::cvt_pk_bf16(gb.x, gb.y); *(GAS v2u*)(ZS + (size_t)(16 * j + t) * 1024 + g * 16 + c0) = w; } } while (0)
    SC_STORE(acc0, 0); SC_STORE(acc1, 1); SC_STORE(acc2, 2); SC_STORE(acc3, 3);
#undef SC_STORE
}

__device__ __forceinline__ float sumsq8(v4u a) { float s = 0.f;
    s += bf2f(a.x & 0xffffu) * bf2f(a.x & 0xffffu) + __uint_as_float(a.x & 0xffff0000u) * __uint_as_float(a.x & 0xffff0000u);
    s += bf2f(a.y & 0xffffu) * bf2f(a.y & 0xffffu) + __uint_as_float(a.y & 0xffff0000u) * __uint_as_float(a.y & 0xffff0000u);
    s += bf2f(a.z & 0xffffu) * bf2f(a.z & 0xffffu) + __uint_as_float(a.z & 0xffff0000u) * __uint_as_float(a.z & 0xffff0000u);
    s += bf2f(a.w & 0xffffu) * bf2f(a.w & 0xffffu) + __uint_as_float(a.w & 0xffff0000u) * __uint_as_float(a.w & 0xffff0000u);
    return s; }
__device__ __forceinline__ unsigned scale2(unsigned w, float s) { return pk2(bf2f(w & 0xffffu) * s, __uint_as_float(w & 0xffff0000u) * s); }
__device__ __forceinline__ v4u scale8(v4u a, float s) { v4u o; o.x = scale2(a.x, s); o.y = scale2(a.y, s); o.z = scale2(a.z, s); o.w = scale2(a.w, s); return o; }
__device__ __forceinline__ void norm_row_item(bf16* yrow, int lane) {
    GAS v4u* p = (GAS v4u*)yrow + lane;
    const v4u a0 = p[0], a1 = p[64], b0 = p[128], b1 = p[192];
    const float ss = wave_sum(sumsq8(a0) + sumsq8(a1)), sa = wave_sum(sumsq8(b0) + sumsq8(b1));
    const float rs = rsqrtf(ss * (1.0f / 1024.0f) + EPS), ra = rsqrtf(sa * (1.0f / 1024.0f) + EPS);
    p[0] = scale8(a0, rs); p[64] = scale8(a1, rs); p[128] = scale8(b0, ra); p[192] = scale8(b1, ra);
}

namespace fox {
constexpr int NW = 8, QBLK = 32, KVBLK = 64, QB = NW * QBLK, D = 128, PITCH = 1024;
constexpr int SHM_V = KVBLK * D * 2, SHM_K = KVBLK * D * 2;
constexpr int LDS_ATT = 2 * SHM_V + 2 * SHM_K + NW * 64 * 4;
constexpr float SCALE = 0.08838834764831845f, THR = 8.f;
typedef short s16x4 __attribute__((ext_vector_type(4)));
#define KSWZ(row, colB) ((row) * 256 + ((colB) ^ (((row) & 7) << 4)))
#define SBAR() __builtin_amdgcn_sched_barrier(0)
__device__ __forceinline__ int v_st(int k, int c) { const int kk = (k & ~0xC) | ((k & 4) << 1) | ((k & 8) >> 1); return ((kk >> 3) * 4 + (c >> 5)) * 512 + ((kk & 7) * 32 + (c & 31)) * 2; }
__device__ __forceinline__ int v_rd_base(int lane) { return ((lane & 3) << 3) | (((lane >> 2) & 3) << 6) | (((lane >> 4) & 1) << 5) | (((lane >> 5) & 1) << 8); }
constexpr int v_rd_off(int d0, int ks, int half) { return d0 * 512 + ks * 4096 + half * 2048; }
__device__ __forceinline__ unsigned cvtpk(float lo, float hi) { unsigned r; asm volatile("v_cvt_pk_bf16_f32 %0, %1, %2" : "=v"(r) : "v"(lo), "v"(hi)); return r; }
__device__ __forceinline__ bf16x8 pack8(f32x4 a, f32x4 b) { v4u w = {cvtpk(a[0], a[1]), cvtpk(a[2], a[3]), cvtpk(b[0], b[1]), cvtpk(b[2], b[3])}; return *reinterpret_cast<bf16x8*>(&w); }
__device__ __forceinline__ bf16x8 ld8(const bf16* p) { return *reinterpret_cast<const bf16x8*>(p); }
__device__ __forceinline__ void mask_tile(f32x16& p0, f32x16& p1, int dq) {
    const float NEG = -__builtin_inff();
#pragma unroll
    for (int r = 0; r < 16; ++r) { const int c = (r & 3) + 8 * (r >> 2); if (dq - c < 0) p0[r] = NEG; if (dq - c - 32 < 0) p1[r] = NEG; }
}
__device__ __forceinline__ void partialSM(f32x16& p0, f32x16& p1, float& m_reg, float& mn, float& alpha) {
    float pmax = p0[0];
#pragma unroll
    for (int r = 1; r < 16; ++r) pmax = fmaxf(pmax, p0[r]);
#pragma unroll
    for (int r = 0; r < 16; ++r) pmax = fmaxf(pmax, p1[r]);
    { auto rr = __builtin_amdgcn_permlane32_swap(__float_as_uint(pmax), __float_as_uint(pmax), false, false); pmax = fmaxf(__uint_as_float(rr[0]), __uint_as_float(rr[1])); }
    constexpr float C2 = 1.4426950408889634f * SCALE;
    if (__builtin_expect(__all((pmax - m_reg) * SCALE <= THR), 1)) { mn = m_reg; alpha = 1.f; }
    else { mn = fmaxf(m_reg, pmax); alpha = __builtin_amdgcn_exp2f((m_reg - mn) * C2); m_reg = mn; }
    const float mnL = -mn * C2;
#pragma unroll
    for (int r = 0; r < 16; ++r) p0[r] = fmaf(p0[r], C2, mnL);
#pragma unroll
    for (int r = 0; r < 16; ++r) p1[r] = fmaf(p1[r], C2, mnL);
#pragma unroll
    for (int r = 0; r < 16; ++r) p0[r] = __builtin_amdgcn_exp2f(p0[r]);
}
__device__ __forceinline__ void finishSM(f32x16& p0, f32x16& p1, float alpha, float& l_reg, bf16x8& pa0, bf16x8& pa1, bf16x8& pa2, bf16x8& pa3) {
#pragma unroll
    for (int r = 0; r < 16; ++r) p1[r] = __builtin_amdgcn_exp2f(p1[r]);
    float ps = 0;
#pragma unroll
    for (int r = 0; r < 16; ++r) ps += p0[r];
#pragma unroll
    for (int r = 0; r < 16; ++r) ps += p1[r];
    { auto rr = __builtin_amdgcn_permlane32_swap(__float_as_uint(ps), __float_as_uint(ps), false, false); ps = __uint_as_float(rr[0]) + __uint_as_float(rr[1]); }
    l_reg = l_reg * alpha + ps;
#define PK4(P, B_, OUT) do { unsigned a0 = cvtpk(P[B_+0], P[B_+1]), a1 = cvtpk(P[B_+2], P[B_+3]); unsigned b0 = cvtpk(P[B_+4], P[B_+5]), b1 = cvtpk(P[B_+6], P[B_+7]); \
        auto r0 = __builtin_amdgcn_permlane32_swap(a0, b0, false, false); auto r1 = __builtin_amdgcn_permlane32_swap(a1, b1, false, false); \
        v4u w = {r0[0], r1[0], r0[1], r1[1]}; OUT = *reinterpret_cast<bf16x8*>(&w); } while (0)
    PK4(p0, 0, pa0); PK4(p0, 8, pa1); PK4(p1, 0, pa2); PK4(p1, 8, pa3);
#undef PK4
}
__device__ __forceinline__ void qkt(f32x16& p0, f32x16& p1, const char* Kt, int r32, int hi, const bf16x8* qr, const bf16* kbp, bf16x8 qone) {
    const bf16x8 kb0 = ld8(kbp), kb1 = ld8(kbp + 32 * 16);
    p0 = f32x16{}; p1 = f32x16{};
    const char* kb[4];
#pragma unroll
    for (int dd = 0; dd < 4; ++dd) kb[dd] = Kt + KSWZ(r32, (dd * 16 + hi * 8) * 2);
#pragma unroll
    for (int d0 = 0; d0 < 8; ++d0) { const char* a = kb[d0 & 3] + (d0 >> 2) * 128;
        bf16x8 b0 = *reinterpret_cast<const bf16x8*>(a); bf16x8 b1 = *reinterpret_cast<const bf16x8*>(a + 32 * 256);
        p0 = MFMA32(b0, qr[d0], p0); p1 = MFMA32(b1, qr[d0], p1); }
    p0 = MFMA32(kb0, qone, p0); p1 = MFMA32(kb1, qone, p1);
}
template <int VOFF>
__device__ __forceinline__ void pv_tile(f32x16* o, int vb0, bf16x8 pa0, bf16x8 pa1, bf16x8 pa2, bf16x8 pa3) {
#define TRRD(dst, off) asm volatile("ds_read_b64_tr_b16 %0, %1 offset:%2" : "=&v"(dst) : "v"(vb0), "i"(off) : "memory")
#define PV_D0(d0) do { s16x4 l0, l1, l2, l3, h0, h1, h2, h3; constexpr int b_ = VOFF + v_rd_off(d0, 0, 0); \
        TRRD(l0, b_); TRRD(h0, b_ + 2048); TRRD(l1, b_ + 4096); TRRD(h1, b_ + 6144); TRRD(l2, b_ + 8192); TRRD(h2, b_ + 10240); TRRD(l3, b_ + 12288); TRRD(h3, b_ + 14336); \
        asm volatile("s_waitcnt lgkmcnt(0)" ::: "memory"); SBAR(); \
        o[d0] = MFMA32(pa0, ((bf16x8){l0[0], l0[1], l0[2], l0[3], h0[0], h0[1], h0[2], h0[3]}), o[d0]); \
        o[d0] = MFMA32(pa1, ((bf16x8){l1[0], l1[1], l1[2], l1[3], h1[0], h1[1], h1[2], h1[3]}), o[d0]); \
        o[d0] = MFMA32(pa2, ((bf16x8){l2[0], l2[1], l2[2], l2[3], h2[0], h2[1], h2[2], h2[3]}), o[d0]); \
        o[d0] = MFMA32(pa3, ((bf16x8){l3[0], l3[1], l3[2], l3[3], h3[0], h3[1], h3[2], h3[3]}), o[d0]); } while (0)
    PV_D0(0); PV_D0(1); PV_D0(2); PV_D0(3);
#undef PV_D0
#undef TRRD
}
__device__ __forceinline__ void store_o(const f32x16* o, const float* li_l, const bf16* SZw, bf16* Ow, int r32, int hi) {
    float rli[16];
#pragma unroll
    for (int r = 0; r < 16; ++r) rli[r] = __builtin_amdgcn_rcpf(li_l[crow(r, hi)]);
#pragma unroll
    for (int r = 0; r < 16; ++r) { const int orow = crow(r, hi);
#pragma unroll
        for (int d0 = 0; d0 < 4; ++d0) { const float z = bf2f(SZw[(size_t)orow * PITCH + d0 * 32 + r32]); const float v = o[d0][r] * rli[r] * z;
            const float vn = __shfl_xor(v, 1);
            if ((r32 & 1) == 0) *(unsigned*)(Ow + (size_t)orow * 2048 + d0 * 32 + r32) = cvtpk(v, vn); } }
}

struct BlockRef { const bf16* Q; const bf16* K; const bf16* V; const bf16* KB; const bf16* SZ; bf16* O; int P0; };
struct Seam { bf16x8 qr[8]; bf16x8 st_v0, st_v1, st_k0, st_k1; };
#define ROW(p, k0, rr) ((p) + (unsigned)(((k0) + (rr)) * PITCH + sc))
#define VMW() asm volatile("s_waitcnt vmcnt(0)" ::: "memory")
#define VMWN(n) asm volatile("s_waitcnt vmcnt(%0)" :: "i"(n) : "memory")
#define SLOAD_H(Kp, Vp, k0) do { S.st_v0 = ld8(ROW(Vp, k0, sr)); S.st_v1 = ld8(ROW(Vp, k0, 32 + sr)); S.st_k0 = ld8(ROW(Kp, k0, sr)); S.st_k1 = ld8(ROW(Kp, k0, 32 + sr)); } while (0)
#define SWRITE_HK(bf) do { *(bf16x8*)(K_lds + (bf) * SHM_K + kws) = S.st_k0; *(bf16x8*)(K_lds + (bf) * SHM_K + kws + 32 * 256) = S.st_k1; } while (0)
#define SWRITE_HV(bf) do { *(bf16x8*)(V_lds + (bf) * SHM_V + vst0) = S.st_v0; *(bf16x8*)(V_lds + (bf) * SHM_V + vst1) = S.st_v1; } while (0)
#define SWRITE_H(bf) do { SWRITE_HV(bf); SWRITE_HK(bf); } while (0)
__device__ __forceinline__ void fox_prime(const BlockRef& cur, char* lds, Seam& S) {
    int tid_ = threadIdx.x; asm volatile("" : "+v"(tid_));
    const int tid = tid_, wid = __builtin_amdgcn_readfirstlane(tid >> 6), lane = tid & 63, r32 = lane & 31, hi = lane >> 5;
    const int sr = tid >> 4, sc = (tid & 15) * 8, kws = KSWZ(sr, sc * 2); char* K_lds = lds + 2 * SHM_V;
#pragma unroll
    for (int d0 = 0; d0 < 8; ++d0) S.qr[d0] = ld8(cur.Q + (size_t)(wid * QBLK + r32) * PITCH + d0 * 16 + hi * 8);
    SLOAD_H(cur.K, cur.V, 0); VMW(); SWRITE_HK(0);
    __syncthreads();
}
__device__ __forceinline__ void fox_block(const BlockRef& cur, const BlockRef& nxt, char* lds, Seam& S, bf16x8 qone) {
    int tid_ = threadIdx.x; asm volatile("" : "+v"(tid_));
    const int tid = tid_, wid = __builtin_amdgcn_readfirstlane(tid >> 6), lane = tid & 63, r32 = lane & 31, hi = lane >> 5;
    const int NT = (cur.P0 + QB - 1) / KVBLK + 1;
    const int qlo = cur.P0 + wid * QBLK, qm = qlo + r32 - 4 * hi;
    char* V_lds = lds; char* K_lds = lds + 2 * SHM_V;
    float* ws = (float*)(lds + 2 * SHM_V + 2 * SHM_K) + wid * 64; float* li_l = ws, * al_l = ws + 32;
    float m_reg = -1e30f, l_reg = 0; f32x16 o[4] = {};
    const int sr = tid >> 4, sc = (tid & 15) * 8, vst0 = v_st(sr, sc), vst1 = v_st(32 + sr, sc), kws = KSWZ(sr, sc * 2);
    const int vb0 = (int)(uintptr_t)V_lds + v_rd_base(lane);
    const bf16* Kh = cur.K; const bf16* Vh = cur.V; const bf16* KBh = cur.KB; const unsigned kbl = (unsigned)(r32 * 16 + hi * 8);
#define RESC(a) do { if (__any((a) < 1.f)) { if (hi == 0) al_l[r32] = (a); asm volatile("s_waitcnt lgkmcnt(0)" ::: "memory"); \
                     _Pragma("unroll") for (int d_ = 0; d_ < 4; ++d_) _Pragma("unroll") for (int r = 0; r < 16; ++r) o[d_][r] *= al_l[crow(r, hi)]; } } while (0)
#define KBASE(t) ((t) * KVBLK)
#define MASKT(P0_, P1_, t) do { const int kb_ = KBASE(t); if (kb_ + KVBLK - 1 > qlo) mask_tile(P0_, P1_, qm - kb_); } while (0)
    constexpr int NQL = 8;
#define SEAM_K0() do { VMWN(NQL); SWRITE_HK(0); SBAR(); } while (0)
    f32x16 pA0, pA1, pB0, pB1; float mnA, mnB, alA, alB; bf16x8 pa0, pa1, pa2, pa3;
    SWRITE_HV(0); SBAR();
    if (NT > 1) SLOAD_H(Kh, Vh, KBASE(1));
    SBAR(); qkt(pA0, pA1, K_lds, r32, hi, S.qr, KBh + kbl, qone);
    MASKT(pA0, pA1, 0); partialSM(pA0, pA1, m_reg, mnA, alA);
    if (NT > 1) { VMW(); SWRITE_H(1); }
    __syncthreads();
#define HALF_STEP(PX0, PX1, mnX, alX, PY0, PY1, alY, t, KBI, VBI, SBI) do { \
        SBAR(); qkt(PX0, PX1, K_lds + (KBI) * SHM_K, r32, hi, S.qr, KBh + (kbl + (unsigned)KBASE(t) * 16u), qone); \
        finishSM(PY0, PY1, alY, l_reg, pa0, pa1, pa2, pa3); SBAR(); \
        if ((t) + 1 < NT) { SLOAD_H(Kh, Vh, KBASE((t) + 1)); SBAR(); } \
        pv_tile<(VBI) * SHM_V>(o, vb0, pa0, pa1, pa2, pa3); MASKT(PX0, PX1, (t)); partialSM(PX0, PX1, m_reg, mnX, alX); \
        __syncthreads(); \
        if ((t) + 1 < NT) { VMW(); SWRITE_H(SBI); } \
        RESC(alX); __syncthreads(); } while (0)
    for (int t = 1; t + 1 < NT; t += 2) {
        HALF_STEP(pB0, pB1, mnB, alB, pA0, pA1, alA, t, 1, 0, 0);
        HALF_STEP(pA0, pA1, mnA, alA, pB0, pB1, alB, t + 1, 0, 1, 1);
    }
    const bool even = (NT & 1) == 0;
    if (even) { SBAR(); qkt(pB0, pB1, K_lds + SHM_K, r32, hi, S.qr, KBh + (kbl + (unsigned)KBASE(NT - 1) * 16u), qone); SBAR(); }
    SLOAD_H(nxt.K, nxt.V, 0); SBAR();
#pragma unroll
    for (int d0 = 0; d0 < 8; ++d0) S.qr[d0] = ld8(nxt.Q + (size_t)(wid * QBLK + r32) * PITCH + d0 * 16 + hi * 8);
    SBAR();
    finishSM(pA0, pA1, alA, l_reg, pa0, pa1, pa2, pa3); SBAR();
    pv_tile<0>(o, vb0, pa0, pa1, pa2, pa3);
    if (even) { MASKT(pB0, pB1, NT - 1); partialSM(pB0, pB1, m_reg, mnB, alB); __syncthreads(); RESC(alB);
        finishSM(pB0, pB1, alB, l_reg, pa0, pa1, pa2, pa3); SBAR(); pv_tile<SHM_V>(o, vb0, pa0, pa1, pa2, pa3); }
    SBAR(); SEAM_K0();
    if (hi == 0) li_l[r32] = l_reg; asm volatile("s_waitcnt lgkmcnt(0)" ::: "memory");
    store_o(o, li_l, cur.SZ + (size_t)(wid * QBLK) * PITCH, cur.O + (size_t)(wid * QBLK) * 2048, r32, hi);
    __syncthreads();
#undef RESC
#undef KBASE
#undef MASKT
#undef SEAM_K0
#undef HALF_STEP
}
__device__ __forceinline__ BlockRef prompt_ref(int bh, int qb, const bf16* Qb, const bf16* Kb, const bf16* Vb, const bf16* KBP, const bf16* SZA, bf16* YN) {
    const int b = bh >> 3, h = bh & 7; const size_t row0 = (size_t)b * P_SEQ + (size_t)qb * QB; BlockRef r;
    r.Q = Qb + row0 * PITCH + h * D; r.K = Kb + (size_t)b * P_SEQ * PITCH + h * D; r.V = Vb + (size_t)b * P_SEQ * PITCH + h * D; r.KB = KBP + (size_t)bh * P_SEQ * 16;
    r.SZ = SZA + row0 * PITCH + h * D; r.O = YN + row0 * 2048 + 1024 + h * D; r.P0 = qb * QB; return r;
}
__device__ __forceinline__ void prompt_attn(int first, int G, const bf16* Qb, const bf16* Kb, const bf16* Vb, const bf16* KBP, const bf16* SZA, bf16* YN, char* lds, bf16x8 qone) {
    int L = first; if (L >= 256) return;
    Seam S; int pass = 0; BlockRef cur = prompt_ref(L >> 4, L & 15, Qb, Kb, Vb, KBP, SZA, YN);
    fox_prime(cur, lds, S);
    for (;;) {
        const bool more_pass = pass == 0, more_item = L + G < 256, last = !more_pass && !more_item;
        int Ln = L, passn = pass + 1; if (!more_pass) { passn = 0; Ln = more_item ? L + G : L; }
        const int yn = Ln & 15; const BlockRef nxt = last ? cur : prompt_ref(Ln >> 4, passn ? 31 - yn : yn, Qb, Kb, Vb, KBP, SZA, YN);
        fox_block(cur, nxt, lds, S, qone);
        if (last) break;
        cur = nxt; pass = passn; L = Ln;
    }
}

__device__ __forceinline__ void fox_sample_unit(int b, int h, const float* cK, const float* cV, const bf16* Kb, const bf16* Vb, const bf16* Qb, const bf16* KBS, const bf16* SZA, bf16* YN, char* lds, bf16x8 qone) {
    int tid_ = threadIdx.x; asm volatile("" : "+v"(tid_));
    const int tid = tid_, wid = __builtin_amdgcn_readfirstlane(tid >> 6), lane = tid & 63, r32 = lane & 31, hi = lane >> 5;
    const int sr = tid >> 4, sc = (tid & 15) * 8, vst0 = v_st(sr, sc), vst1 = v_st(32 + sr, sc), kws = KSWZ(sr, sc * 2);
    char* V_lds = lds; char* K_lds = lds + 2 * SHM_V;
    float* ws = (float*)(lds + 2 * SHM_V + 2 * SHM_K) + wid * 64; float* li_l = ws, * al_l = ws + 32;
    const int vb0 = (int)(uintptr_t)V_lds + v_rd_base(lane);
    const size_t rowq = (size_t)MP + (size_t)b * S_SEQ;
    const float* ck = cK + ((size_t)b * PAST) * 1024 + h * D + sc; const float* cv = cV + ((size_t)b * PAST) * 1024 + h * D + sc;
    const bf16* nk = Kb + rowq * PITCH + h * D + sc; const bf16* nv = Vb + rowq * PITCH + h * D + sc;
    const bf16* kbp = KBS + ((size_t)(b * 8 + h) * (PAST + S_SEQ) + r32) * 16 + hi * 8;
    const int wq = wid & 1;
    bf16x8 qr[8];
#pragma unroll
    for (int d0 = 0; d0 < 8; ++d0) qr[d0] = ld8(Qb + (rowq + wq * 32 + r32) * PITCH + h * D + d0 * 16 + hi * 8);
    float m_reg = -1e30f, l_reg = 0; f32x16 o[4] = {};
    f32x4 kf0, kf1, kf2, kf3, vf0, vf1, vf2, vf3;
#define LOADF(t) do { const float* kp_ = ck + (size_t)((t) * KVBLK + sr) * 1024; const float* vp_ = cv + (size_t)((t) * KVBLK + sr) * 1024; \
        kf0 = *(const f32x4*)kp_; kf1 = *(const f32x4*)(kp_ + 4); kf2 = *(const f32x4*)(kp_ + 32 * 1024); kf3 = *(const f32x4*)(kp_ + 32 * 1024 + 4); \
        vf0 = *(const f32x4*)vp_; vf1 = *(const f32x4*)(vp_ + 4); vf2 = *(const f32x4*)(vp_ + 32 * 1024); vf3 = *(const f32x4*)(vp_ + 32 * 1024 + 4); } while (0)
#define WRITEF(bf) do { *(bf16x8*)(K_lds + (bf) * SHM_K + kws) = pack8(kf0, kf1); *(bf16x8*)(K_lds + (bf) * SHM_K + kws + 32 * 256) = pack8(kf2, kf3); \
        *(bf16x8*)(V_lds + (bf) * SHM_V + vst0) = pack8(vf0, vf1); *(bf16x8*)(V_lds + (bf) * SHM_V + vst1) = pack8(vf2, vf3); } while (0)
#define LOADH() do { kf0 = *(const f32x4*)(nk + (size_t)sr * PITCH); kf1 = *(const f32x4*)(nk + (size_t)(32 + sr) * PITCH); vf0 = *(const f32x4*)(nv + (size_t)sr * PITCH); vf1 = *(const f32x4*)(nv + (size_t)(32 + sr) * PITCH); } while (0)
#define WRITEH(bf) do { *(f32x4*)(K_lds + (bf) * SHM_K + kws) = kf0; *(f32x4*)(K_lds + (bf) * SHM_K + kws + 32 * 256) = kf1; \
        *(f32x4*)(V_lds + (bf) * SHM_V + vst0) = vf0; *(f32x4*)(V_lds + (bf) * SHM_V + vst1) = vf1; } while (0)
#define RESC(a) do { if (__any((a) < 1.f)) { if (hi == 0) al_l[r32] = (a); asm volatile("s_waitcnt lgkmcnt(0)" ::: "memory"); \
                     _Pragma("unroll") for (int d_ = 0; d_ < 4; ++d_) _Pragma("unroll") for (int r = 0; r < 16; ++r) o[d_][r] *= al_l[crow(r, hi)]; } } while (0)
    constexpr int NTS = PAST / KVBLK + 1;
    LOADF(0);
    VMW(); WRITEF(0); __syncthreads();
#pragma unroll 1
    for (int t = 0; t < NTS; t += 2) {
#define SSTEP(tt, BUF) do { \
        if ((tt) + 1 < NTS - 1) { LOADF((tt) + 1); } else if ((tt) + 1 == NTS - 1) { LOADH(); } \
        if (wid < 2) { f32x16 p0, p1; float mn, al; bf16x8 pa0, pa1, pa2, pa3; \
            qkt(p0, p1, K_lds + (BUF) * SHM_K, r32, hi, qr, kbp + (size_t)((tt) * KVBLK) * 16, qone); \
            if ((tt) == NTS - 1) mask_tile(p0, p1, wid * QBLK + r32 - 4 * hi); \
            partialSM(p0, p1, m_reg, mn, al); RESC(al); finishSM(p0, p1, al, l_reg, pa0, pa1, pa2, pa3); SBAR(); \
            pv_tile<(BUF) * SHM_V>(o, vb0, pa0, pa1, pa2, pa3); } \
        if ((tt) + 1 < NTS) { VMW(); if ((tt) + 1 < NTS - 1) { WRITEF((BUF) ^ 1); } else { WRITEH((BUF) ^ 1); } } \
        __syncthreads(); } while (0)
        SSTEP(t, 0);
        if (t + 1 < NTS) SSTEP(t + 1, 1);
#undef SSTEP
    }
    if (wid < 2) { if (hi == 0) li_l[r32] = l_reg; asm volatile("s_waitcnt lgkmcnt(0)" ::: "memory");
        store_o(o, li_l, SZA + (rowq + wid * QBLK) * PITCH + h * D, YN + (rowq + wid * QBLK) * 2048 + 1024 + h * D, r32, hi); }
    __syncthreads();
#undef LOADF
#undef WRITEF
#undef LOADH
#undef WRITEH
#undef RESC
}
#undef ROW
#undef VMW
#undef VMWN
#undef SLOAD_H
#undef SWRITE_HK
#undef SWRITE_HV
#undef SWRITE_H
#undef KSWZ
#undef SBAR
}
#define STAGE_B_PHASES \
          \
        if (IN(ph + 3)) { PHASE_PTRS; const bf16* BCl = (const bf16*)(ws + WS_BC) + (size_t)l * 64 * 256 * 384; \
            for (int it = gw; it < 64 * 36 * 2; it += NGW) sc_item(it, Ub, HS, BCl, ZS, lane); } \
        SEAM(ph + 3); \
          \
        if (IN(ph + 4)) { PHASE_PTRS; \
            pg8::Gemm g{ZS, (const bf16*)(ws + WS_WGLU) + (size_t)l * 1024 * 1024, MROWS, 1024, 1024}; pg8::StaticOrder S; S.init(MROWS, 1024, G, (int)blockIdx.x); \
            pg8::EpiGlu E{ws, inp[21] + l * 1024}; \
            pg8::gemm_phase<pg8::EpiGlu, pg8::StaticOrder, true, true>(lds + RING_OFF, g, S, E); \
        } \
        SEAM(ph + 4); \
          \
        if (IN(ph + 5)) { PHASE_PTRS; \
            bf16x8 qone = {0, 0, 0, 0, 0, 0, 0, 0}; if ((tid & 32) == 0) { qone[0] = (short)0x3F80; qone[1] = (short)0x3F80; qone[2] = (short)0x3F80; } \
            for (int u = vcu; u < 256; u += G) fox::fox_sample_unit(u >> 3, u & 7, inp[2] + (size_t)l * 32 * PAST * 1024, inp[3] + (size_t)l * 32 * PAST * 1024, Kb, Vb, Qb, KBS, SZA, YN, (char*)lds_raw, qone); \
            fox::prompt_attn(vcu, G, Qb, Kb, Vb, KBP, SZA, YN, (char*)lds_raw, qone); \
        } \
        SEAM(ph + 5); \
          \
        if (IN(ph + 6)) { PHASE_PTRS; for (int m = gw; m < MROWS; m += NGW) norm_row_item(YN + (size_t)m * 2048, lane); } \
        SEAM(ph + 6); \
          \
        if (IN(ph + 7)) { PHASE_PTRS; \
            pg8::Gemm g{YN, (const bf16*)(ws + WS_WOUT) + (size_t)l * 2048 * 2048, MROWS, 2048, 2048}; pg8::StaticOrder S; S.init(MROWS, 2048, G, (int)blockIdx.x); \
            pg8::EpiOut E{l == 0 ? inp[0] : (const float*)out, l == 0 ? inp[1] : (const float*)(out + O_YS), out, ws, l}; \
            pg8::gemm_phase<pg8::EpiOut, pg8::StaticOrder, true, true>(lds + RING_OFF, g, S, E); \
        } \
        SEAM(ph + 7); \


constexpr int PH_PER_LAYER = 8, N_PHASES = 1 + DEPTH * PH_PER_LAYER;

struct Args { const float* in[25]; float* out; unsigned char* ws; int ph_lo, ph_hi; };
__global__ void __launch_bounds__(NWAVES * 64, 2) fwd_kernel(Args args) {
    extern __shared__ __attribute__((aligned(16))) unsigned char lds_raw[];
    LAS unsigned char* lds = (LAS unsigned char*)lds_raw;
    const int tid0 = threadIdx.x;
    const int G = gridDim.x; const int bx = blockIdx.x; const int vcu = (G % 8 == 0) ? (bx % 8) * (G / 8) + bx / 8 : bx;
    unsigned* ctl = (unsigned*)(args.ws + WS_CTL);
    volatile LAS unsigned* MISC = (volatile LAS unsigned*)(lds + MISC_OFF);
    if (tid0 < 32) MISC[tid0] = 0u;
    __syncthreads();
    const int lo = args.ph_lo, hi = args.ph_hi;
    const bool multi = (hi - lo) > 1;
    XcdBarrier bar; bar.bar = ctl + CW_BAR; bar.x = 0; bar.st = nullptr;
    if (multi) bar = xcd_barrier_post(ctl + CW_BAR, MISC + 8);
#define IN(k) (lo <= (k) && (k) < hi)
#define SEAM(k) do { if (IN(k) && IN((k) + 1)) xcd_barrier(bar); } while (0)
#define PHASE_PTRS int z_ = 0; int tid = tid0; asm volatile("" : "+s"(z_), "+v"(tid)); const int lane = tid & 63, wave = __builtin_amdgcn_readfirstlane(tid >> 6), gw = vcu * NWAVES + wave, NGW = G * NWAVES; (void)lane; (void)gw; (void)NGW; const float* const* inp = args.in + z_; unsigned char* ws = args.ws + z_; float* out = args.out + z_; float* rowsq = (float*)(ws + WS_CTL) + CW_ROWSQ; (void)inp; (void)out; (void)rowsq
#define XB ((bf16*)(ws + WS_XB))
#define Ub ((bf16*)(ws + WS_U))
#define SZS ((bf16*)(ws + WS_SZS))
#define Qb ((bf16*)(ws + WS_Q))
#define Kb ((bf16*)(ws + WS_K))
#define Vb ((bf16*)(ws + WS_V))
#define SZA ((bf16*)(ws + WS_SZA))
#define ZS ((bf16*)(ws + WS_ZS))
#define YN ((bf16*)(ws + WS_YN))
#define E16 ((float*)(ws + WS_E16))
#define HS ((bf16*)(ws + WS_HS))
#define LOGF ((float*)(ws + WS_LOGF))
#define KBP ((bf16*)(ws + WS_KBP))
#define KBS ((bf16*)(ws + WS_KBS))

    if (IN(0)) { PHASE_PTRS; p0_prologue(inp, ws, lds, tid, wave, lane, vcu, G); }
    SEAM(0);

    for (int l = 0; l < N_LAYERS_RUN; ++l) {
        const int ph = 1 + l * PH_PER_LAYER;
        if (IN(ph + 0)) { PHASE_PTRS;
            pg8::Gemm g{XB, (const bf16*)(ws + WS_WIN) + (size_t)l * N_IN * 2048, MROWS, N_IN, 2048}; pg8::StaticOrder S; S.init(MROWS, N_IN, G, (int)blockIdx.x);
            pg8::EpiIn E{ws, out, inp[10] + l * 128, inp[11] + l * 128, l, (LAS float*)(lds + RED_OFF)};
            pg8::gemm_phase<pg8::EpiIn, pg8::StaticOrder, true, true>(lds + RING_OFF, g, S, E);
        }
        SEAM(ph + 0);
        if (IN(ph + 1)) { PHASE_PTRS;
            const bf16* WTl = (const bf16*)(ws + WS_WT) + (size_t)l * 64 * 128 * 256;
            for (int it = gw; it < 64 * 36 * 2; it += NGW) e16_item(it, Ub, WTl, E16, lane);
            for (int it = gw; it < MROWS / 16; it += NGW) fpre_item(it, XB, (const bf16*)(ws + WS_WF) + (size_t)l * 16 * 2048, rowsq + (size_t)l * MROWS, inp[9] + l * 8, LOGF,
                                                                out + O_LFP + (size_t)l * MP * 8, out + O_LFS + (size_t)l * MS * 8, lane);
        }
        SEAM(ph + 1);
        if (IN(ph + 2)) { PHASE_PTRS;
            const float* A16l = (const float*)(ws + WS_A16) + (size_t)l * 64 * 64 * 2;
            for (int it = vcu; it < 128 + 16; it += G) {
                if (it < 128) carry_prompt_item(it, E16, A16l, HS, out + O_HRP + (size_t)l * 2 * 64 * 64, out + O_HIP + (size_t)l * 2 * 64 * 64, (LAS float*)(lds + RING_OFF), wave, lane);
                else cumsum_prompt_item(it - 128, LOGF, KBP, (LAS float*)(lds + RING_OFF), tid, wave, lane);
            }
            for (int it = gw; it < 2048 + 256; it += NGW) {
                if (it < 2048) carry_sample_item(it, E16, A16l, inp[5] + (size_t)l * 32 * 64 * 64, inp[6] + (size_t)l * 32 * 64 * 64, HS, out + O_HRS + (size_t)l * 32 * 64 * 64, out + O_HIS + (size_t)l * 32 * 64 * 64, lane);
                else cumsum_sample_item(it - 2048, inp[4] + (size_t)l * 32 * PAST * 8, LOGF, KBS, lane);
            }
        }
        SEAM(ph + 2);
        STAGE_B_PHASES
    }
#undef IN
#undef SEAM
}

extern "C" void kernel_launch(void* const* d_in, const int* in_sizes, int n_in, void* d_out, int out_size, void* d_ws, size_t ws_size, hipStream_t stream) {
    static int grid = 0;
    if (grid == 0) {
        if (n_in != 25 || (size_t)out_size != O_END || ws_size < WS_END) { fprintf(stderr, "kernel_launch: unexpected shapes (n_in %d out %d ws %zu, need ws %zu)\n", n_in, out_size, ws_size, (size_t)WS_END); grid = -1; return; }
        int dev = 0, cus = 0, per_cu = 0;
        if (hipGetDevice(&dev) != hipSuccess || hipDeviceGetAttribute(&cus, hipDeviceAttributeMultiprocessorCount, dev) != hipSuccess) { grid = -1; return; }
        if (hipFuncSetAttribute((const void*)fwd_kernel, hipFuncAttributeMaxDynamicSharedMemorySize, LDS_BYTES) != hipSuccess) { fprintf(stderr, "kernel_launch: hipFuncSetAttribute failed\n"); grid = -1; return; }
        if (hipOccupancyMaxActiveBlocksPerMultiprocessor(&per_cu, (const void*)fwd_kernel, NWAVES * 64, LDS_BYTES) != hipSuccess || per_cu < 1) { fprintf(stderr, "kernel_launch: occupancy query says %d\n", per_cu); }
        (void)hipGetLastError();
        grid = cus;
    }
    if (grid < 0) return;
    if (hipMemsetAsync((char*)d_ws + WS_CTL, 0, CTL_ZERO_BYTES, stream) != hipSuccess) return;
#if STAGE_ZERO_OUT
    (void)hipMemsetAsync(d_out, 0, (size_t)out_size * 4, stream);
#endif
    Args a{};
    for (int i = 0; i < 25; ++i) a.in[i] = (const float*)d_in[i];
    a.out = (float*)d_out; a.ws = (unsigned char*)d_ws;
#if ONE_LAUNCH
    a.ph_lo = 0; a.ph_hi = N_PHASES;
    hipLaunchKernelGGL(fwd_kernel, dim3(grid), dim3(NWAVES * 64), LDS_BYTES, stream, a);
#else
    for (int p = 0; p < N_PHASES; ++p) { a.ph_lo = p; a.ph_hi = p + 1; hipLaunchKernelGGL(fwd_kernel, dim3(grid), dim3(NWAVES * 64), LDS_BYTES, stream, a); }
#endif
}
```

```cpp
#include <hip/hip_runtime.h>
#include <cstdio>
#include <cstdint>

constexpr int D_MODEL = 2048, DEPTH = 4, N_HEADS = 8, HEAD_DIM = 128, N_GROUPS = 64, STATE_DIM = 64, SSM_GROUP = 16;
constexpr int P_BATCH = 2, P_SEQ = 8192, S_BATCH = 32, S_SEQ = 64, PAST = 1024;
constexpr int MP = P_BATCH * P_SEQ;
constexpr int MS = S_BATCH * S_SEQ;
constexpr int MROWS = MP + MS;
constexpr int D_HALF = 1024, D_PROJ = 6152, N_IN = 6144;
constexpr int NSUB = MROWS / 16;
constexpr float EPS = 1e-6f;
constexpr float SQRT_HD = 11.313708498984761f;

constexpr size_t MiB = 1u << 20;
constexpr size_t WS_CTL = 0, CTL_ZERO_BYTES = 2 * MiB;
constexpr size_t WS_A16  = 2 * MiB;
constexpr size_t WS_WF   = 3 * MiB;
constexpr size_t WS_WIN  = 4 * MiB;
constexpr size_t WS_WGLU = WS_WIN + 4ull * N_IN * 2048 * 2;
constexpr size_t WS_WOUT = WS_WGLU + 4ull * 1024 * 1024 * 2;
constexpr size_t WS_WT   = WS_WOUT + 4ull * 2048 * 2048 * 2;
constexpr size_t WS_BC   = WS_WT + 4ull * 64 * 128 * 256 * 2;
constexpr size_t WS_XB   = WS_BC + 4ull * 64 * 256 * 384 * 2;
constexpr size_t WS_U    = WS_XB + (size_t)MROWS * 2048 * 2;
constexpr size_t WS_SZS  = WS_U + (size_t)MROWS * 1024 * 2;
constexpr size_t WS_Q    = WS_SZS + (size_t)MROWS * 1024 * 2;
constexpr size_t WS_K    = WS_Q + (size_t)MROWS * 1024 * 2;
constexpr size_t WS_V    = WS_K + (size_t)MROWS * 1024 * 2;
constexpr size_t WS_SZA  = WS_V + (size_t)MROWS * 1024 * 2;
constexpr size_t WS_ZS   = WS_SZA + (size_t)MROWS * 1024 * 2;
constexpr size_t WS_YN   = WS_ZS + (size_t)MROWS * 1024 * 2;
constexpr size_t WS_E16  = WS_YN + (size_t)MROWS * 2048 * 2;
constexpr size_t WS_HS   = WS_E16 + (size_t)NSUB * 64 * 128 * 4;
constexpr size_t WS_LOGF = WS_HS + (size_t)NSUB * 64 * 128 * 2;
constexpr size_t WS_KBP  = WS_LOGF + (size_t)MROWS * 8 * 4;
constexpr size_t WS_KBS  = WS_KBP + 16ull * 8192 * 16 * 2;
constexpr size_t WS_JLO  = WS_KBS + 256ull * 1088 * 16 * 2;
constexpr size_t WS_UB   = WS_JLO + 4096;
constexpr size_t WS_END  = WS_UB + 4096;
constexpr float ACP_T = 30.0f;
constexpr int CW_BAR = 4096;
constexpr int CW_ROWSQ = 65536;
static_assert((CW_ROWSQ + 5 * MROWS) * 4 <= (int)CTL_ZERO_BYTES, "CTL words inside the memset region");

constexpr size_t O_YP = 0, O_YS = O_YP + (size_t)MP * 2048, O_KP = O_YS + (size_t)MS * 2048, O_VP = O_KP + 4ull * MP * 1024, O_LFP = O_VP + 4ull * MP * 1024,
                 O_HRP = O_LFP + 4ull * MP * 8, O_HIP = O_HRP + 4ull * 2 * 64 * 64, O_KS = O_HIP + 4ull * 2 * 64 * 64, O_VS = O_KS + 4ull * MS * 1024, O_LFS = O_VS + 4ull * MS * 1024,
                 O_HRS = O_LFS + 4ull * MS * 8, O_HIS = O_HRS + 4ull * 32 * 64 * 64, O_END = O_HIS + 4ull * 32 * 64 * 64;
static_assert(O_END == 190447616ull, "output size");

#ifndef N_LAYERS_RUN
#define N_LAYERS_RUN 4
#endif
#define STAGE_ZERO_OUT 0
#ifndef DUP_IN
#define DUP_IN 0
#endif
#ifndef DUP_S5
#define DUP_S5 0
#endif
#ifndef DUP_GLU
#define DUP_GLU 0
#endif
#ifndef DUP_AS
#define DUP_AS 0
#endif
#ifndef DUP_AP
#define DUP_AP 0
#endif
#ifndef DUP_P0
#define DUP_P0 0
#endif
#ifndef DUP_NORM
#define DUP_NORM 0
#endif
#ifndef ONE_LAUNCH
#define ONE_LAUNCH 1
#endif
namespace pg8 {
#define PG8_LAS __attribute__((address_space(3)))
typedef unsigned short bf16_t;
typedef short bf16x8 __attribute__((ext_vector_type(8)));
typedef float f32x4 __attribute__((ext_vector_type(4)));
typedef unsigned u32x4 __attribute__((ext_vector_type(4)));
constexpr int BM = 256, BK = 64, HALF = 128, HTB = HALF * BK * 2  , STAGE_BYTES = 8 * HTB, NXCD = 8, WGM = 8;

__host__ __device__ __forceinline__ int lds_byte(int r, int c) { const int st = (r >> 4) * 2 + (c >> 5), rr = r & 15, cc = c & 31, ob = rr * 64 + cc * 2; return st * 1024 + (ob ^ (((ob >> 9) & 1) << 5)); }
__host__ __device__ __forceinline__ void stage_rc(int b, int& R, int& C) { const int st = b / 1024, sb = b % 1024, swz = sb ^ (((sb >> 9) & 1) << 5); R = (st >> 1) * 16 + swz / 64; C = (st & 1) * 32 + (swz % 64) / 2; }
__host__ __device__ __forceinline__ int perm32(int rho) { const int n = rho >> 4, i = rho & 15; return 8 * (i >> 2) + 4 * n + (i & 3); }

struct Unit { int pm, pn; };
struct Gemm { const bf16_t* A; const bf16_t* Bt; int M, N, K; };

struct StaticOrder {
    int nM, nN, nwg, G, c;
    __host__ __device__ void init(int M, int N, int G_, int c_) { nM = M / BM; nN = N / BM; nwg = nM * nN; G = G_; c = c_; }
    __host__ __device__ bool next(int i, Unit& u) const {
        const long L = (long)i * G + c; if (L >= nwg) return false;
        int wgid = (int)L; { const int q = nwg / NXCD, r = nwg % NXCD, xcd = wgid % NXCD, off = wgid / NXCD; wgid = (xcd < r ? xcd * (q + 1) : r * (q + 1) + (xcd - r) * q) + off; }
        const int nig = WGM * nN, gid = wgid / nig, fm = gid * WGM, gsz = (nM - fm) < WGM ? (nM - fm) : WGM;
        u.pm = fm + ((wgid % nig) % gsz); u.pn = (wgid % nig) / gsz; return true;
    }
    __device__ __forceinline__ void a_ready(const Unit&) const {}
    __device__ __forceinline__ void done(const Unit&) const {}
};

__device__ __forceinline__ unsigned cvt_pk_bf16(float lo, float hi) { unsigned r; asm volatile("v_cvt_pk_bf16_f32 %0, %1, %2" : "=v"(r) : "v"(lo), "v"(hi)); return r; }
typedef float f32x2 __attribute__((ext_vector_type(2)));
__device__ __forceinline__ f32x2 gelu_pk(f32x2 v) {
    const f32x2 av = __builtin_elementwise_abs(v), d = av * 0.2316418882f + 1.0f;
    f32x2 t; t.x = __builtin_amdgcn_rcpf(d.x); t.y = __builtin_amdgcn_rcpf(d.y);
    f32x2 q = t * 0.5307027145f + (-0.7265760135f); q = q * t + 0.7107068705f; q = q * t + (-0.142248368f); q = q * t + 0.127414796f; q = q * t;
    const f32x2 s = (v * v) * (-0.72134752044f);
    f32x2 e; e.x = __builtin_amdgcn_exp2f(s.x); e.y = __builtin_amdgcn_exp2f(s.y);
    const f32x2 m = v * (q * e), r = v - m;
    f32x2 o; o.x = v.x < 0.f ? m.x : r.x; o.y = v.y < 0.f ? m.y : r.y; return o;
}

__device__ __forceinline__ float bf_lo(unsigned w) { return __uint_as_float(w << 16); }
__device__ __forceinline__ float bf_hi(unsigned w) { return __uint_as_float(w & 0xffff0000u); }
__device__ __forceinline__ float fast_sigmoid(float v) { return __builtin_amdgcn_rcpf(1.0f + __builtin_amdgcn_exp2f(-1.4426950408889634f * v)); }
__device__ __forceinline__ u32x4 pack8f(const f32x4 a, const f32x4 b) { u32x4 w; w.x = cvt_pk_bf16(a[0], a[1]); w.y = cvt_pk_bf16(a[2], a[3]); w.z = cvt_pk_bf16(b[0], b[1]); w.w = cvt_pk_bf16(b[2], b[3]); return w; }

struct EpiIn {
    static constexpr bool PERM = true, AFTER_DRAIN = false;
    unsigned char* ws; float* out; const float *qg, *kg; int l;
    PG8_LAS float* red;
    __device__ __forceinline__ void operator()(const f32x4 (&acc)[2][2][4][2], const Unit& u, int wr, int wc, int fr, int fq) const {
        const float* rowsq = (const float*)(ws + WS_CTL) + CW_ROWSQ + (size_t)l * MROWS;
        bf16_t* U = (bf16_t*)(ws + WS_U); bf16_t* SZS = (bf16_t*)(ws + WS_SZS); bf16_t* Q = (bf16_t*)(ws + WS_Q); bf16_t* K = (bf16_t*)(ws + WS_K); bf16_t* V = (bf16_t*)(ws + WS_V); bf16_t* SZA = (bf16_t*)(ws + WS_SZA);
        float* kout_p = out + O_KP + (size_t)l * MP * 1024; float* kout_s = out + O_KS + (size_t)l * MS * 1024; float* vout_p = out + O_VP + (size_t)l * MP * 1024; float* vout_s = out + O_VS + (size_t)l * MS * 1024;
        const int region = u.pn >> 2, ct = (u.pn & 3) * 256;
        const int rt = wr * 64 + fr, row0 = u.pm * BM + rt, cw = wc * 32 + 8 * fq;
        float rs[2][4];
#pragma unroll
        for (int ai = 0; ai < 2; ++ai)
#pragma unroll
            for (int m = 0; m < 4; ++m) rs[ai][m] = rsqrtf(rowsq[row0 + ai * HALF + m * 16] * (1.0f / 2048.0f) + EPS);
        if (region == 0) {
#pragma unroll
            for (int ai = 0; ai < 2; ++ai)
#pragma unroll
                for (int m = 0; m < 4; ++m) { const int row = row0 + ai * HALF + m * 16; const float s = rs[ai][m];
#pragma unroll
                    for (int bj = 0; bj < 2; ++bj) { const int col = ct + bj * HALF + cw; const int g = col >> 4, c0 = col & 15;
                        *(u32x4*)(U + ((size_t)g * MROWS + row) * 16 + c0) = pack8f(acc[ai][bj][m][0] * s, acc[ai][bj][m][1] * s); } }
        } else if (region == 1 || region == 5) {
            bf16_t* dst = region == 1 ? SZS : SZA;
#pragma unroll
            for (int ai = 0; ai < 2; ++ai)
#pragma unroll
                for (int m = 0; m < 4; ++m) { const int row = row0 + ai * HALF + m * 16; const float s = rs[ai][m];
#pragma unroll
                    for (int bj = 0; bj < 2; ++bj) { f32x4 a = acc[ai][bj][m][0] * s, b = acc[ai][bj][m][1] * s;
#pragma unroll
                        for (int i = 0; i < 4; ++i) { a[i] = a[i] * fast_sigmoid(a[i]); b[i] = b[i] * fast_sigmoid(b[i]); }
                        *(u32x4*)(dst + (size_t)row * 1024 + ct + bj * HALF + cw) = pack8f(a, b); } }
        } else if (region == 4) {
            float* vo = (u.pm < MP / BM) ? vout_p + (size_t)row0 * 1024 : vout_s + (size_t)(row0 - MP) * 1024;
#pragma unroll
            for (int ai = 0; ai < 2; ++ai)
#pragma unroll
                for (int m = 0; m < 4; ++m) { const int ro = ai * HALF + m * 16; const float s = rs[ai][m];
#pragma unroll
                    for (int bj = 0; bj < 2; ++bj) { const f32x4 a = acc[ai][bj][m][0] * s, b = acc[ai][bj][m][1] * s; const int col = ct + bj * HALF + cw;
                        *(u32x4*)(V + (size_t)(row0 + ro) * 1024 + col) = pack8f(a, b);
                        *(f32x4*)(vo + (size_t)ro * 1024 + col) = a; *(f32x4*)(vo + (size_t)ro * 1024 + col + 4) = b; } }
        } else {
#pragma unroll
            for (int ai = 0; ai < 2; ++ai)
#pragma unroll
                for (int m = 0; m < 4; ++m) { const float s = rs[ai][m];
#pragma unroll
                    for (int bj = 0; bj < 2; ++bj) { const f32x4 a = acc[ai][bj][m][0] * s, b = acc[ai][bj][m][1] * s;
                        float q = (a[0] * a[0] + a[1] * a[1]) + (a[2] * a[2] + a[3] * a[3]) + (b[0] * b[0] + b[1] * b[1]) + (b[2] * b[2] + b[3] * b[3]);
                        q += __shfl_xor(q, 16); q += __shfl_xor(q, 32);
                        if (fq == 0) red[((ai * HALF + wr * 64 + m * 16 + fr) * 2 + bj) * 4 + wc] = q; } }
            asm volatile("s_waitcnt lgkmcnt(0)" ::: "memory"); __builtin_amdgcn_s_barrier(); asm volatile("" ::: "memory");
            const float* gp = (region == 2 ? qg : kg) + cw;
            const f32x4 g0 = *(const f32x4*)gp, g1 = *(const f32x4*)(gp + 4);
            bf16_t* dst = region == 2 ? Q : K;
            float* ko = (u.pm < MP / BM) ? kout_p + (size_t)row0 * 1024 : kout_s + (size_t)(row0 - MP) * 1024;
#pragma unroll
            for (int ai = 0; ai < 2; ++ai)
#pragma unroll
                for (int m = 0; m < 4; ++m) { const int ro = ai * HALF + m * 16;
#pragma unroll
                    for (int bj = 0; bj < 2; ++bj) { const f32x4 t = *(const PG8_LAS f32x4*)(red + ((ai * HALF + wr * 64 + m * 16 + fr) * 2 + bj) * 4);
                        const float sc = rsqrtf(((t[0] + t[1]) + (t[2] + t[3])) * (1.0f / 128.0f) + EPS) * rs[ai][m];
                        const f32x4 a = acc[ai][bj][m][0] * sc * g0, b = acc[ai][bj][m][1] * sc * g1; const int col = ct + bj * HALF + cw;
                        *(u32x4*)(dst + (size_t)(row0 + ro) * 1024 + col) = pack8f(a, b);
                        if (region == 3) { *(f32x4*)(ko + (size_t)ro * 1024 + col) = a; *(f32x4*)(ko + (size_t)ro * 1024 + col + 4) = b; } } }
        }
    }
};

struct EpiGlu {
    static constexpr bool PERM = true, AFTER_DRAIN = false;
    unsigned char* ws; const float* bias;
    __device__ __forceinline__ void operator()(const f32x4 (&acc)[2][2][4][2], const Unit& u, int wr, int wc, int fr, int fq) const {
        const bf16_t* ZS = (const bf16_t*)(ws + WS_ZS); const bf16_t* SZS = (const bf16_t*)(ws + WS_SZS); bf16_t* YN = (bf16_t*)(ws + WS_YN);
        const int row0 = u.pm * BM + wr * 64 + fr, c0 = u.pn * BM + wc * 32 + 8 * fq;
#pragma unroll
        for (int bj = 0; bj < 2; ++bj) { const int col = c0 + bj * HALF; const f32x4 b0 = *(const f32x4*)(bias + col), b1 = *(const f32x4*)(bias + col + 4);
#pragma unroll
            for (int ai = 0; ai < 2; ++ai)
#pragma unroll
                for (int m = 0; m < 4; ++m) { const size_t row = (size_t)(row0 + ai * HALF + m * 16);
                    const u32x4 z = *(const u32x4*)(ZS + row * 1024 + col), s = *(const u32x4*)(SZS + row * 1024 + col);
                    const f32x4 v0 = acc[ai][bj][m][0] + b0, v1 = acc[ai][bj][m][1] + b1; f32x4 o0, o1;
                    o0[0] = bf_lo(z.x) * fast_sigmoid(v0[0]) * bf_lo(s.x); o0[1] = bf_hi(z.x) * fast_sigmoid(v0[1]) * bf_hi(s.x);
                    o0[2] = bf_lo(z.y) * fast_sigmoid(v0[2]) * bf_lo(s.y); o0[3] = bf_hi(z.y) * fast_sigmoid(v0[3]) * bf_hi(s.y);
                    o1[0] = bf_lo(z.z) * fast_sigmoid(v1[0]) * bf_lo(s.z); o1[1] = bf_hi(z.z) * fast_sigmoid(v1[1]) * bf_hi(s.z);
                    o1[2] = bf_lo(z.w) * fast_sigmoid(v1[2]) * bf_lo(s.w); o1[3] = bf_hi(z.w) * fast_sigmoid(v1[3]) * bf_hi(s.w);
                    *(u32x4*)(YN + row * 2048 + col) = pack8f(o0, o1); } }
    }
};

struct EpiOut {
    static constexpr bool PERM = true, AFTER_DRAIN = false;
    const float* xin_p; const float* xin_s; float* xout; unsigned char* ws; int l;
    __device__ __forceinline__ void operator()(const f32x4 (&acc)[2][2][4][2], const Unit& u, int wr, int wc, int fr, int fq) const {
        bf16_t* XB = (bf16_t*)(ws + WS_XB); float* rowsq_next = (float*)(ws + WS_CTL) + CW_ROWSQ + (size_t)(l + 1) * MROWS;
        const int row0 = u.pm * BM + wr * 64 + fr, c0 = u.pn * BM + wc * 32 + 8 * fq;
        const float* xi = (u.pm < MP / BM) ? xin_p + (size_t)row0 * 2048 : xin_s + (size_t)(row0 - MP) * 2048;
#pragma unroll
        for (int ai = 0; ai < 2; ++ai)
#pragma unroll
            for (int m = 0; m < 4; ++m) { const int ro = ai * HALF + m * 16; float ss = 0.f;
#pragma unroll
                for (int bj = 0; bj < 2; ++bj) { const int col = c0 + bj * HALF;
                    const f32x4 a = *(const f32x4*)(xi + (size_t)ro * 2048 + col) + acc[ai][bj][m][0], b = *(const f32x4*)(xi + (size_t)ro * 2048 + col + 4) + acc[ai][bj][m][1];
                    *(f32x4*)(xout + (size_t)(row0 + ro) * 2048 + col) = a; *(f32x4*)(xout + (size_t)(row0 + ro) * 2048 + col + 4) = b;
                    *(u32x4*)(XB + (size_t)(row0 + ro) * 2048 + col) = pack8f(a, b);
                    ss += (a[0] * a[0] + a[1] * a[1]) + (a[2] * a[2] + a[3] * a[3]) + (b[0] * b[0] + b[1] * b[1]) + (b[2] * b[2] + b[3] * b[3]); }
                ss += __shfl_xor(ss, 16); ss += __shfl_xor(ss, 32);
                if (fq == 0) unsafeAtomicAdd(rowsq_next + row0 + ro, ss); }
    }
};
template <class Epi, class Sched, bool ALIGN_EPI = false, bool SP2 = false>
__device__ __forceinline__ void gemm_phase(PG8_LAS unsigned char* lds, const Gemm g, const Sched& S, const Epi& E) {
    int tid_ = threadIdx.x; asm volatile("" : "+v"(tid_));
    const int tid = tid_, wid = __builtin_amdgcn_readfirstlane(tid >> 6), lane = tid & 63, wr = wid >> 2, wc = wid & 3, fr = lane & 15, fq = lane >> 4;
    const int K = g.K, nt = K / BK;
    unsigned voffA[2], voffB[2];
#pragma unroll
    for (int i = 0; i < 2; ++i) { int R, C; stage_rc(tid * 16 + i * 8192, R, C); const int Rb = Epi::PERM ? ((R & ~31) + perm32(R & 31)) : R;
        voffA[i] = (unsigned)(R * K + C) * 2u; voffB[i] = (unsigned)(Rb * K + C) * 2u; }
    const size_t kstep = (size_t)(BK * 2);
    const size_t hstep = (size_t)HALF * K * 2;
    const size_t tstep = 2 * hstep;
    const unsigned ldsw = (unsigned)wid * 1024u;
    const int aoff = lds_byte(wr * 64 + fr, fq * 8), boff = lds_byte(wc * 32 + fr, fq * 8);
#define PG8_SA(b, h) (((b) * 2 + (h)) * HTB)
#define PG8_SB(b, h) ((4 + (b) * 2 + (h)) * HTB)
#define PG8_STAGE(bufoff, gbase, voff) do { _Pragma("unroll") for (int _i = 0; _i < 2; ++_i) \
        __builtin_amdgcn_global_load_lds((const unsigned*)((const char*)(gbase) + (voff)[_i]), (PG8_LAS unsigned*)(lds + (bufoff) + ldsw + _i * 8192), 16, 0, 0); } while (0)
#define PG8_LDA(dst, b, h) do { _Pragma("unroll") for (int m = 0; m < 4; ++m) _Pragma("unroll") for (int k = 0; k < 2; ++k) dst[m][k] = *(const PG8_LAS bf16x8*)(lds + PG8_SA(b, h) + aoff + m * 2048 + k * 1024); } while (0)
#define PG8_LDB(dst, b, h) do { _Pragma("unroll") for (int n = 0; n < 2; ++n) _Pragma("unroll") for (int k = 0; k < 2; ++k) dst[n][k] = *(const PG8_LAS bf16x8*)(lds + PG8_SB(b, h) + boff + n * 2048 + k * 1024); } while (0)
#define PG8_MMA(ai, bj, At, Bt) do { __builtin_amdgcn_s_setprio(1); _Pragma("unroll") for (int m = 0; m < 4; ++m) _Pragma("unroll") for (int n = 0; n < 2; ++n) _Pragma("unroll") for (int k = 0; k < 2; ++k) \
        acc[ai][bj][m][n] = __builtin_amdgcn_mfma_f32_16x16x32_bf16(Bt[n][k], At[m][k], acc[ai][bj][m][n], 0, 0, 0); __builtin_amdgcn_s_setprio(0); } while (0)
#define PG8_WAIT_V(n) asm volatile("s_waitcnt vmcnt(" #n ")" ::: "memory")
#define PG8_WAIT_L(n) asm volatile("s_waitcnt lgkmcnt(" #n ")" ::: "memory")
#define PG8_BAR __builtin_amdgcn_s_barrier()
#define PG8_SCHED __builtin_amdgcn_sched_barrier(0)
    Unit cur, nxt; int ui = 0;
    if (!S.next(0, cur)) return;
    f32x4 acc[2][2][4][2];
#pragma unroll
    for (int a = 0; a < 2; ++a)
#pragma unroll
        for (int b = 0; b < 2; ++b)
#pragma unroll
            for (int m = 0; m < 4; ++m)
#pragma unroll
                for (int n = 0; n < 2; ++n) acc[a][b][m][n] = (f32x4){0.f, 0.f, 0.f, 0.f};
    bf16x8 At[4][2], B0[2][2], B1[2][2];
    const char* cA = (const char*)g.A + (size_t)cur.pm * tstep; const char* cB = (const char*)g.Bt + (size_t)cur.pn * tstep;
    S.a_ready(cur);
    if constexpr (SP2) {
        PG8_STAGE(PG8_SB(0, 0), cB, voffB); PG8_STAGE(PG8_SB(0, 1), cB + hstep, voffB); PG8_STAGE(PG8_SA(0, 0), cA, voffA); PG8_STAGE(PG8_SA(0, 1), cA + hstep, voffA);
        if (wr == 1) PG8_BAR;
        PG8_WAIT_V(2); PG8_BAR;
        PG8_STAGE(PG8_SB(1, 0), cB + kstep, voffB); PG8_STAGE(PG8_SA(1, 0), cA + kstep, voffA); PG8_STAGE(PG8_SB(1, 1), cB + hstep + kstep, voffB);
        PG8_WAIT_V(6); PG8_BAR;
    } else {
        PG8_STAGE(PG8_SB(0, 0), cB, voffB); PG8_STAGE(PG8_SA(0, 0), cA, voffA); PG8_STAGE(PG8_SB(0, 1), cB + hstep, voffB); PG8_STAGE(PG8_SA(0, 1), cA + hstep, voffA);
        if (wr == 1) PG8_BAR;
        PG8_WAIT_V(4); PG8_BAR;
        PG8_STAGE(PG8_SB(1, 0), cB + kstep, voffB); PG8_STAGE(PG8_SA(1, 0), cA + kstep, voffA); PG8_STAGE(PG8_SB(1, 1), cB + hstep + kstep, voffB);
        PG8_WAIT_V(6); PG8_BAR;
    }
    for (;;) {
        const bool has_next = S.next(ui + 1, nxt);
        const char* nA = has_next ? (const char*)g.A + (size_t)nxt.pm * tstep : cA; const char* nB = has_next ? (const char*)g.Bt + (size_t)nxt.pn * tstep : cB;
        for (int t = 0; t < nt; t += 2) {
            const bool last = (t == nt - 2);
            const char* a1 = cA + (size_t)(t + 1) * kstep;
            const char* a2 = last ? nA : cA + (size_t)(t + 2) * kstep; const char* b2 = last ? nB : cB + (size_t)(t + 2) * kstep;
            const char* a3 = a2 + kstep; const char* b3 = b2 + kstep;
            if (last && has_next) S.a_ready(nxt);
            if constexpr (SP2) {
            PG8_LDB(B0, 0, 0); PG8_LDB(B1, 0, 1); PG8_SCHED; PG8_LDA(At, 0, 0); PG8_STAGE(PG8_SA(1, 1), a1 + hstep, voffA);
            PG8_WAIT_V(8); PG8_WAIT_L(0); PG8_BAR; PG8_MMA(0, 0, At, B0); PG8_MMA(0, 1, At, B1); PG8_BAR; PG8_SCHED;
            PG8_LDA(At, 0, 1); PG8_STAGE(PG8_SB(0, 0), b2, voffB); PG8_STAGE(PG8_SB(0, 1), b2 + hstep, voffB); PG8_STAGE(PG8_SA(0, 0), a2, voffA);
            PG8_WAIT_V(8); PG8_WAIT_L(0); PG8_BAR; PG8_MMA(1, 0, At, B0); PG8_MMA(1, 1, At, B1); PG8_BAR; PG8_SCHED;
            PG8_LDB(B0, 1, 0); PG8_LDB(B1, 1, 1); PG8_SCHED; PG8_LDA(At, 1, 0); PG8_STAGE(PG8_SA(0, 1), a2 + hstep, voffA);
            PG8_WAIT_V(8); PG8_WAIT_L(0); PG8_BAR; PG8_MMA(0, 0, At, B0); PG8_MMA(0, 1, At, B1); PG8_BAR; PG8_SCHED;
            PG8_LDA(At, 1, 1); PG8_STAGE(PG8_SB(1, 0), b3, voffB); PG8_STAGE(PG8_SB(1, 1), b3 + hstep, voffB); PG8_STAGE(PG8_SA(1, 0), a3, voffA);
            PG8_WAIT_V(8); PG8_WAIT_L(0); PG8_BAR; PG8_MMA(1, 0, At, B0); PG8_MMA(1, 1, At, B1); PG8_BAR; PG8_SCHED;
            } else {
            PG8_LDB(B0, 0, 0); PG8_SCHED; PG8_LDA(At, 0, 0); PG8_STAGE(PG8_SA(1, 1), a1 + hstep, voffA);
            PG8_WAIT_L(8); PG8_BAR; PG8_WAIT_L(0); PG8_MMA(0, 0, At, B0); PG8_BAR; PG8_SCHED;
            PG8_LDB(B1, 0, 1); PG8_STAGE(PG8_SB(0, 0), b2, voffB);
            PG8_BAR; PG8_WAIT_L(0); PG8_MMA(0, 1, At, B1); PG8_BAR;
            PG8_LDA(At, 0, 1); PG8_STAGE(PG8_SA(0, 0), a2, voffA);
            PG8_BAR; PG8_WAIT_L(0); PG8_MMA(1, 0, At, B0); PG8_BAR; PG8_SCHED;
            PG8_STAGE(PG8_SB(0, 1), b2 + hstep, voffB);
            PG8_WAIT_V(6); PG8_BAR; PG8_MMA(1, 1, At, B1); PG8_BAR;
            PG8_LDB(B0, 1, 0); PG8_SCHED; PG8_LDA(At, 1, 0); PG8_STAGE(PG8_SA(0, 1), a2 + hstep, voffA);
            PG8_WAIT_L(8); PG8_BAR; PG8_WAIT_L(0); PG8_MMA(0, 0, At, B0); PG8_BAR; PG8_SCHED;
            PG8_LDB(B1, 1, 1); PG8_STAGE(PG8_SB(1, 0), b3, voffB);
            PG8_BAR; PG8_WAIT_L(0); PG8_MMA(0, 1, At, B1); PG8_BAR;
            PG8_LDA(At, 1, 1); PG8_STAGE(PG8_SA(1, 0), a3, voffA);
            PG8_BAR; PG8_WAIT_L(0); PG8_MMA(1, 0, At, B0); PG8_BAR; PG8_SCHED;
            PG8_STAGE(PG8_SB(1, 1), b3 + hstep, voffB);
            PG8_WAIT_V(6); PG8_BAR; PG8_MMA(1, 1, At, B1); PG8_BAR;
            }
        }
        if constexpr (ALIGN_EPI) { if (wr == 0) PG8_BAR; }
        if constexpr (!Epi::AFTER_DRAIN) { E(acc, cur, wr, wc, fr, fq); S.done(cur); }
        if (!has_next) break;
#pragma unroll
        for (int a = 0; a < 2; ++a)
#pragma unroll
            for (int b = 0; b < 2; ++b)
#pragma unroll
                for (int m = 0; m < 4; ++m)
#pragma unroll
                    for (int n = 0; n < 2; ++n) acc[a][b][m][n] = (f32x4){0.f, 0.f, 0.f, 0.f};
        cur = nxt; cA = nA; cB = nB; ++ui;
        if constexpr (ALIGN_EPI) { if (wr == 1) PG8_BAR; }
    }
    PG8_WAIT_V(0);
    if constexpr (!ALIGN_EPI) { if (wr == 0) PG8_BAR; }
    PG8_BAR;
    if constexpr (Epi::AFTER_DRAIN) { E.fused(acc, cur, wr, wc, fr, fq, lds, wid, lane); S.done(cur); }
#undef PG8_SA
#undef PG8_SB
#undef PG8_STAGE
#undef PG8_LDA
#undef PG8_LDB
#undef PG8_MMA
#undef PG8_WAIT_V
#undef PG8_WAIT_L
#undef PG8_BAR
#undef PG8_SCHED
}
}

constexpr int RING_OFF = 0, RING_BYTES = 131072;
constexpr int RED_OFF = RING_BYTES;
constexpr int MISC_OFF = RED_OFF + 8192;
constexpr int LDS_BYTES = 147456;
static_assert(MISC_OFF + 128 <= LDS_BYTES, "LDS map");
constexpr int NWAVES = 8;

#define GAS __attribute__((address_space(1)))
#define LAS __attribute__((address_space(3)))
typedef unsigned short bf16;
typedef unsigned v4u __attribute__((ext_vector_type(4)));
typedef unsigned v2u __attribute__((ext_vector_type(2)));
typedef float f32x4 __attribute__((ext_vector_type(4)));
typedef float f32x16 __attribute__((ext_vector_type(16)));
typedef short bf16x8 __attribute__((ext_vector_type(8)));
#define LDS_WAIT() asm volatile("s_waitcnt lgkmcnt(0)" ::: "memory")
#define VM_WAIT() asm volatile("s_waitcnt vmcnt(0)" ::: "memory")
__device__ __forceinline__ unsigned f2bf(float f) { unsigned u = __builtin_bit_cast(unsigned, f); return (u + 0x7fffu + ((u >> 16) & 1u)) >> 16; }
__device__ __forceinline__ unsigned pk2(float lo, float hi) { return f2bf(lo) | (f2bf(hi) << 16); }
__device__ __forceinline__ float bf2f(unsigned h) { return __uint_as_float(h << 16); }
__device__ __forceinline__ float wave_sum(float v) {
#pragma unroll
    for (int o = 1; o < 64; o <<= 1) v += __shfl_xor(v, o);
    return v;
}
#define XB_TMO      128
#define XB_XCNT(j)  (256  + 64 * (j))
#define XB_XSUB(j)  (1280 + 64 * (j))
#define XB_XGEN(j)  (2304 + 64 * (j))
#define XB_TOP      3328
#define XB_TOPGEN   3392
#define XCD_BAR_WORDS 3456
#define XB_SPIN_CAP (1u << 18)

__device__ __forceinline__ unsigned xb_ld(unsigned* p)              { return __hip_atomic_load(p, __ATOMIC_RELAXED, __HIP_MEMORY_SCOPE_AGENT); }
__device__ __forceinline__ unsigned xb_add(unsigned* p, unsigned v) { return __hip_atomic_fetch_add(p, v, __ATOMIC_RELAXED, __HIP_MEMORY_SCOPE_AGENT); }
__device__ __forceinline__ unsigned xb_xcc_id() { return (unsigned)__builtin_amdgcn_s_getreg((3 << 11) | 20) & 0xFu; }
#define XB_SPIN(cond, bar) do { unsigned _sp = 0; while (cond) { __builtin_amdgcn_s_sleep(1); \
    if ((++_sp & 255u) == 0u) { if (xb_ld(&(bar)[XB_TMO])) break; if (_sp > XB_SPIN_CAP) { atomicAdd(&(bar)[XB_TMO], 1u); break; } } } } while (0)

struct XcdBarrier {
    unsigned* bar; unsigned x;
    volatile LAS unsigned* st;
};

__device__ __forceinline__ XcdBarrier xcd_barrier_post(unsigned* bar, volatile LAS unsigned* st) {
    XcdBarrier b; b.bar = bar; b.x = xb_xcc_id(); b.st = st;
    if (threadIdx.x == 0) (void)xb_add(&bar[XB_XCNT(b.x)], 1u);
    return b;
}
__device__ __forceinline__ void xcd_barrier_complete(unsigned* bar, unsigned x, unsigned& nloc, unsigned& nx) {
    const unsigned G = gridDim.x * gridDim.y * gridDim.z;
    unsigned sum, cnt, mine, sp = 0u;
    for (;;) {
        sum = 0u; cnt = 0u; mine = 0u;
#pragma unroll
        for (unsigned j = 0; j < 16; ++j) { const unsigned c = xb_ld(&bar[XB_XCNT(j)]); sum += c; cnt += (c > 0u) ? 1u : 0u; mine = (j == x) ? c : mine; }
        if (sum == G) break;
        __builtin_amdgcn_s_sleep(1);
        if ((++sp & 255u) == 0u) { if (xb_ld(&bar[XB_TMO])) break; if (sp > XB_SPIN_CAP) { atomicAdd(&bar[XB_TMO], 1u); break; } }
    }
    nloc = mine > 0u ? mine : 1u; nx = cnt > 0u ? cnt : 1u;
}

__device__ __forceinline__ void xcd_barrier(const XcdBarrier& b) {
    asm volatile("s_waitcnt vmcnt(0)" ::: "memory");
    __syncthreads();
    if (threadIdx.x == 0) {
        unsigned* bar = b.bar;
        __builtin_amdgcn_s_waitcnt(0);
        unsigned nloc = b.st[0], nx = b.st[1];
        if (nloc == 0u) { xcd_barrier_complete(bar, b.x, nloc, nx); b.st[0] = nloc; b.st[1] = nx; }
        const unsigned old = xb_add(&bar[XB_XSUB(b.x)], 1u);
        const unsigned gen = old / nloc;
        if (old + 1u == (gen + 1u) * nloc) {
            __builtin_amdgcn_fence(__ATOMIC_RELEASE, "agent");
            asm volatile("s_waitcnt vmcnt(0)" ::: "memory");
            const unsigned og = xb_add(&bar[XB_TOP], 1u);
            const unsigned tg = og / nx;
            if (og + 1u == (tg + 1u) * nx) xb_add(&bar[XB_TOPGEN], 1u);
            else XB_SPIN(xb_ld(&bar[XB_TOPGEN]) == tg, bar);
            __builtin_amdgcn_fence(__ATOMIC_ACQUIRE, "agent");
            xb_add(&bar[XB_XGEN(b.x)], 1u);
            asm volatile("s_waitcnt vmcnt(0)" ::: "memory");
        } else {
            XB_SPIN(xb_ld(&bar[XB_XGEN(b.x)]) == gen, bar);
            __builtin_amdgcn_fence(__ATOMIC_ACQUIRE, "agent");
            asm volatile("s_waitcnt vmcnt(0)" ::: "memory");
        }
    }
    __syncthreads();
}

__device__ __forceinline__ int crow(int r, int hi) { return (r & 3) + 8 * (r >> 2) + 4 * hi; }
#define MFMA32(a, b, c) __builtin_amdgcn_mfma_f32_32x32x16_bf16((a), (b), (c), 0, 0, 0)
#define MFMA16(a, b, c) __builtin_amdgcn_mfma_f32_16x16x32_bf16((a), (b), (c), 0, 0, 0)

__device__ __forceinline__ void dsincos(double x, double& s, double& c) {
    const double k = __builtin_rint(x * 0.63661977236758134308);
    double r = __builtin_fma(-k, 1.57079632679489655800e+00, x); r = __builtin_fma(-k, 6.12323399573676603587e-17, r);
    const double r2 = r * r;
    double sp = -7.6471637318198164759e-13;
    sp = sp * r2 + 1.6059043836821614599e-10; sp = sp * r2 - 2.5052108385441718775e-08; sp = sp * r2 + 2.7557319223985890653e-06;
    sp = sp * r2 - 1.9841269841269841270e-04; sp = sp * r2 + 8.3333333333333333333e-03; sp = sp * r2 - 1.6666666666666666667e-01;
    const double sr = r + r * r2 * sp;
    double cp = 4.7794773323873852974e-14;
    cp = cp * r2 - 1.1470745597729724714e-11; cp = cp * r2 + 2.0876756987868098979e-09; cp = cp * r2 - 2.7557319223985890653e-07;
    cp = cp * r2 + 2.4801587301587301587e-05; cp = cp * r2 - 1.3888888888888888889e-03; cp = cp * r2 + 4.1666666666666666667e-02; cp = cp * r2 - 0.5;
    const double cr = 1.0 + r2 * cp;
    const int q = ((int)k) & 3;
    s = (q == 0) ? sr : (q == 1) ? cr : (q == 2) ? -sr : -cr;
    c = (q == 0) ? cr : (q == 1) ? -sr : (q == 2) ? -cr : sr;
}

__device__ __forceinline__ void p0_transpose_item(const float* W, int ldw, int K, bf16* WT, const float* gain, LAS float* scr, int kb, int nb, int lane) {
    const int k0 = 64 * kb, n0 = 32 * nb;
#pragma unroll 8
    for (int i = 0; i < 32; ++i) { const int kk = 2 * i + (lane >> 5); float v = W[(size_t)(k0 + kk) * ldw + n0 + (lane & 31)]; if (gain) v *= gain[k0 + kk]; scr[kk * 33 + (lane & 31)] = v; }
    LDS_WAIT(); asm volatile("" ::: "memory");
    const int c = lane & 7;
#pragma unroll
    for (int j = 0; j < 4; ++j) { const int n = (lane >> 3) + 8 * j; const LAS float* s = scr + (8 * c) * 33 + n;
        v4u o; o.x = pk2(s[0 * 33], s[1 * 33]); o.y = pk2(s[2 * 33], s[3 * 33]); o.z = pk2(s[4 * 33], s[5 * 33]); o.w = pk2(s[6 * 33], s[7 * 33]);
        *(GAS v4u*)(WT + (size_t)(n0 + n) * K + k0 + 8 * c) = o; }
    LDS_WAIT(); asm volatile("" ::: "memory");
}

__device__ __forceinline__ void p0_s5_item(int l, int g, const float* const* in, bf16* WT, bf16* BC, float* A16, float* UB, LAS float* scr, int tid) {
    LAS float* PWR = scr; LAS float* PWI = scr + 1088; LAS float* BPR = scr + 2176; LAS float* BPI = scr + 3200;
    LAS float* CR = scr + 4224; LAS float* CI = scr + 5248; LAS float* KL = scr + 6272; LAS float* DD = scr + 10368;
    const int lg = l * 64 + g;
    if (tid < 64) {
        const int p = tid;
        const double dt = exp((double)in[12][lg]);
        const double ar = (double)in[13][lg * 64 + p], ai = (double)in[14][lg * 64 + p];
        const double mag = exp(ar * dt); double sn, cs; dsincos(ai * dt, sn, cs);
        const double abr = mag * cs, abi = mag * sn;
        const double den = ar * ar + ai * ai, nr = abr - 1.0, ni = abi;
        const double cfr = (nr * ar + ni * ai) / den, cfi = (ni * ar - nr * ai) / den;
        double pr = 1.0, pi = 0.0;
        for (int n = 0; n <= 16; ++n) { PWR[n * 64 + p] = (float)pr; PWI[n * 64 + p] = (float)pi; const double t = pr * abr - pi * abi; pi = pr * abi + pi * abr; pr = t; }
        A16[(g * 64 + p) * 2] = PWR[16 * 64 + p]; A16[(g * 64 + p) * 2 + 1] = PWI[16 * 64 + p];
        const float* br = in[15] + ((size_t)lg * 64 + p) * 16; const float* bi = in[16] + ((size_t)lg * 64 + p) * 16;
        for (int c = 0; c < 16; ++c) { const double x = br[c], y = bi[c]; BPR[p * 16 + c] = (float)(cfr * x - cfi * y); BPI[p * 16 + c] = (float)(cfr * y + cfi * x); }
    } else {
        for (int i = tid - 64; i < 1024; i += 448) { CR[i] = in[17][(size_t)lg * 1024 + i]; CI[i] = in[18][(size_t)lg * 1024 + i]; }
        if (tid < 80) DD[tid - 64] = in[19][lg * 16 + tid - 64];
        if (g == 0 && tid >= 448) {
            const int i = tid - 448; float mq = fmaxf(fabsf(in[10][l * 128 + i]), fabsf(in[10][l * 128 + 64 + i])), mk = fmaxf(fabsf(in[11][l * 128 + i]), fabsf(in[11][l * 128 + 64 + i]));
#pragma unroll
            for (int o = 1; o < 64; o <<= 1) { mq = fmaxf(mq, __shfl_xor(mq, o)); mk = fmaxf(mk, __shfl_xor(mk, o)); }
            if (i == 0) UB[l] = SQRT_HD * mq * mk * 1.01f; }
    }
    __syncthreads();
    for (int o = tid; o < 4096; o += 512) { const int lag = o >> 8, c = (o >> 4) & 15, cp = o & 15; float a = 0.f;
        for (int p = 0; p < 64; ++p) { const float pr = PWR[lag * 64 + p], pi = PWI[lag * 64 + p], br = BPR[p * 16 + cp], bi = BPI[p * 16 + cp];
            a += CR[c * 64 + p] * (pr * br - pi * bi) - CI[c * 64 + p] * (pr * bi + pi * br); }
        if (lag == 0 && c == cp) a += DD[c];
        KL[o] = a; }
    __syncthreads();
    bf16* bc = BC + (size_t)g * 256 * 384;
    for (int q = tid; q < 12288; q += 512) { const int n = q / 48, k0 = (q % 48) * 8, t = n >> 4, c = n & 15; float v[8];
        if (k0 < 256) { const int s = k0 >> 4, cp0 = k0 & 15;
#pragma unroll
            for (int e = 0; e < 8; ++e) v[e] = (s <= t) ? KL[(t - s) * 256 + c * 16 + cp0 + e] : 0.f;
        } else { const int kk0 = k0 - 256; const bool im = kk0 >= 64; const int p0 = im ? kk0 - 64 : kk0;
#pragma unroll
            for (int e = 0; e < 8; ++e) { const int p = p0 + e; const float cr = CR[c * 64 + p], ci = CI[c * 64 + p], pr = PWR[(t + 1) * 64 + p], pi = PWI[(t + 1) * 64 + p];
                v[e] = im ? -(cr * pi + ci * pr) : (cr * pr - ci * pi); } }
        v4u o; o.x = pk2(v[0], v[1]); o.y = pk2(v[2], v[3]); o.z = pk2(v[4], v[5]); o.w = pk2(v[6], v[7]);
        *(GAS v4u*)(bc + (size_t)n * 384 + k0) = o; }
    bf16* wt = WT + (size_t)g * 128 * 256;
    for (int q = tid; q < 4096; q += 512) { const int n = q >> 5, k0 = (q & 31) * 8, s = k0 >> 4, cp0 = k0 & 15, p = n & 63; const bool im = n >= 64; float v[8];
        const float pr = PWR[(15 - s) * 64 + p], pi = PWI[(15 - s) * 64 + p];
#pragma unroll
        for (int e = 0; e < 8; ++e) { const float br = BPR[p * 16 + cp0 + e], bi = BPI[p * 16 + cp0 + e]; v[e] = im ? (pr * bi + pi * br) : (pr * br - pi * bi); }
        v4u o; o.x = pk2(v[0], v[1]); o.y = pk2(v[2], v[3]); o.z = pk2(v[4], v[5]); o.w = pk2(v[6], v[7]);
        *(GAS v4u*)(wt + (size_t)n * 256 + k0) = o; }
    __syncthreads();
}

__device__ __forceinline__ void p0_row_item(const float* xrow, bf16* orow, float* rsq, int lane) {
    const GAS f32x4* xr = (const GAS f32x4*)xrow + lane; GAS v2u* o8 = (GAS v2u*)orow + lane; float s = 0.f;
#pragma unroll
    for (int j = 0; j < 8; ++j) { const f32x4 v = xr[64 * j]; s += (v[0] * v[0] + v[1] * v[1]) + (v[2] * v[2] + v[3] * v[3]); v2u w; w.x = pk2(v[0], v[1]); w.y = pk2(v[2], v[3]); o8[64 * j] = w; }
    s = wave_sum(s);
    if (lane == 0) *rsq = s;
}

__device__ __forceinline__ void p0_prologue(const float* const* in, unsigned char* ws, LAS unsigned char* lds, int tid, int wave, int lane, int vcu, int G) {
    for (int it = vcu; it < DEPTH * 64; it += G) { const int l = it >> 6, g = it & 63;
        p0_s5_item(l, g, in, (bf16*)(ws + WS_WT) + (size_t)l * 64 * 128 * 256, (bf16*)(ws + WS_BC) + (size_t)l * 64 * 256 * 384, (float*)(ws + WS_A16) + (size_t)l * 64 * 64 * 2, (float*)(ws + WS_UB), (LAS float*)(lds + RING_OFF), tid); }
    LAS float* scr = (LAS float*)(lds + RING_OFF + wave * 16384);
    const int gw = vcu * NWAVES + wave, NGW = G * NWAVES;
    constexpr int I_IN = 32 * 192, I_GLU = 16 * 32, I_OUT = 32 * 64, PER_L = I_IN + I_GLU + I_OUT;
    for (int it = gw; it < DEPTH * PER_L; it += NGW) { const int l = it / PER_L; int r = it - l * PER_L;
        if (r < I_IN) { p0_transpose_item(in[8] + (size_t)l * 2048 * D_PROJ, D_PROJ, 2048, (bf16*)(ws + WS_WIN) + (size_t)l * N_IN * 2048, in[7] + l * 2048, scr, r / 192, r % 192, lane); continue; } r -= I_IN;
        if (r < I_GLU) { p0_transpose_item(in[20] + (size_t)l * 1024 * 1024, 1024, 1024, (bf16*)(ws + WS_WGLU) + (size_t)l * 1024 * 1024, nullptr, scr, r / 32, r % 32, lane); continue; } r -= I_GLU;
        { const int kb = r / 64; const float* gn = (kb < 16) ? in[22] + l * 1024 : in[23] + l * 1024 - 1024;
          p0_transpose_item(in[24] + (size_t)l * 2048 * 2048, 2048, 2048, (bf16*)(ws + WS_WOUT) + (size_t)l * 2048 * 2048, gn, scr, kb, r % 64, lane); } }
    for (int it = gw; it < DEPTH * 16; it += NGW) { const int l = it >> 4, h = it & 15; bf16* wf = (bf16*)(ws + WS_WF) + (size_t)it * 2048;
        for (int k = lane; k < 2048; k += 64) { const float v = (h < 8) ? in[7][l * 2048 + k] * in[8][((size_t)l * 2048 + k) * D_PROJ + N_IN + h] : 0.f; wf[k] = (bf16)f2bf(v); } }
    float* rowsq0 = (float*)(ws + WS_CTL) + CW_ROWSQ;
    for (int m = gw; m < MROWS; m += NGW) { const float* xr = (m < MP) ? in[0] + (size_t)m * 2048 : in[1] + (size_t)(m - MP) * 2048;
        p0_row_item(xr, (bf16*)(ws + WS_XB) + (size_t)m * 2048, rowsq0 + m, lane); }
}

__device__ __forceinline__ float log_sigmoid(float x) { return (x >= 0.f) ? -log1pf(expf(-x)) : x - log1pf(expf(x)); }

__device__ __forceinline__ void fpre_item(int item, const bf16* XB, const bf16* WF, const float* rowsq, const float* bfv, float* LOGF, float* out_p, float* out_s, int lane) {
    const int row0 = item * 16, fr = lane & 15, fq = lane >> 4;
    const bf16* a = XB + (size_t)(row0 + fr) * 2048 + 8 * fq; const bf16* b = WF + (size_t)fr * 2048 + 8 * fq;
    f32x4 acc = {0.f, 0.f, 0.f, 0.f};
#pragma unroll 8
    for (int kk = 0; kk < 64; ++kk) { const bf16x8 av = *(const bf16x8*)(a + kk * 32), bv = *(const bf16x8*)(b + kk * 32); acc = MFMA16(av, bv, acc); }
    if (fr < 8) {
#pragma unroll
        for (int i = 0; i < 4; ++i) { const int row = row0 + 4 * fq + i; const float rs = rsqrtf(rowsq[row] * (1.0f / 2048.0f) + EPS);
            const float lf = log_sigmoid(acc[i] * rs + bfv[fr]); LOGF[row * 8 + fr] = lf;
            if (row < MP) out_p[row * 8 + fr] = lf; else out_s[(row - MP) * 8 + fr] = lf; } }
}

__device__ __forceinline__ void e16_item(int item, const bf16* U, const bf16* WT, float* E16, int lane) {
    const int nh = item & 1, t2 = item >> 1, jb = t2 % 36, g = t2 / 36, r32 = lane & 31, hi = lane >> 5;
    const bf16* bp = U + ((size_t)g * MROWS + (size_t)(jb * 32 + r32) * 16) * 16 + 8 * hi;
    const bf16* ap = WT + ((size_t)(g * 128 + nh * 64 + r32)) * 256 + 8 * hi;
    f32x16 acc0 = {}, acc1 = {};
#pragma unroll 4
    for (int s = 0; s < 16; ++s) { const bf16x8 b = *(const bf16x8*)(bp + 16 * s); const bf16x8 a0 = *(const bf16x8*)(ap + 16 * s), a1 = *(const bf16x8*)(ap + 32 * 256 + 16 * s);
        acc0 = MFMA32(a0, b, acc0); acc1 = MFMA32(a1, b, acc1); }
    float* ep = E16 + ((size_t)(jb * 32 + r32) * 64 + g) * 128 + nh * 64 + 4 * hi;
#pragma unroll
    for (int rq = 0; rq < 4; ++rq) { *(f32x4*)(ep + 8 * rq) = (f32x4){acc0[4 * rq], acc0[4 * rq + 1], acc0[4 * rq + 2], acc0[4 * rq + 3]};
        *(f32x4*)(ep + 32 + 8 * rq) = (f32x4){acc1[4 * rq], acc1[4 * rq + 1], acc1[4 * rq + 2], acc1[4 * rq + 3]}; }
}

__device__ __forceinline__ void carry_prompt_item(int item, const float* E16, const float* A16, bf16* HS, float* out_re, float* out_im, LAS float* scr, int wave, int lane) {
    const int b = item >> 6, g = item & 63, p = lane;
    const float ar = A16[(g * 64 + p) * 2], ai = A16[(g * 64 + p) * 2 + 1];
    const int j0 = b * 512 + wave * 64;
    const float* ep = E16 + ((size_t)j0 * 64 + g) * 128 + p;
    float hr = 0.f, hm = 0.f;
#pragma unroll 1
    for (int jb = 0; jb < 2; ++jb) { float er[32], ei[32];
#pragma unroll
        for (int j = 0; j < 32; ++j) { er[j] = ep[(size_t)(jb * 32 + j) * 8192]; ei[j] = ep[(size_t)(jb * 32 + j) * 8192 + 64]; }
#pragma unroll
        for (int j = 0; j < 32; ++j) { const float nr = ar * hr - ai * hm + er[j], ni = ar * hm + ai * hr + ei[j]; hr = nr; hm = ni; } }
    scr[(wave * 64 + p) * 2] = hr; scr[(wave * 64 + p) * 2 + 1] = hm;
    float sr = ar, si = ai;
#pragma unroll
    for (int q = 0; q < 6; ++q) { const float t = sr * sr - si * si; si = 2.f * sr * si; sr = t; }
    LDS_WAIT(); __syncthreads();
    float cr = 0.f, ci = 0.f;
    for (int v = 0; v < wave; ++v) { const float xr = scr[(v * 64 + p) * 2], xi = scr[(v * 64 + p) * 2 + 1]; const float nr = sr * cr - si * ci + xr, ni = sr * ci + si * cr + xi; cr = nr; ci = ni; }
    bf16* hp = HS + ((size_t)j0 * 64 + g) * 128 + p;
    hr = cr; hm = ci; asm volatile("" ::: "memory");
#pragma unroll 1
    for (int jb = 0; jb < 2; ++jb) { float er[32], ei[32];
#pragma unroll
        for (int j = 0; j < 32; ++j) { er[j] = ep[(size_t)(jb * 32 + j) * 8192]; ei[j] = ep[(size_t)(jb * 32 + j) * 8192 + 64]; }
#pragma unroll
        for (int j = 0; j < 32; ++j) { hp[(size_t)(jb * 32 + j) * 8192] = (bf16)f2bf(hr); hp[(size_t)(jb * 32 + j) * 8192 + 64] = (bf16)f2bf(hm);
            const float nr = ar * hr - ai * hm + er[j], ni = ar * hm + ai * hr + ei[j]; hr = nr; hm = ni; } }
    if (wave == 7) { out_re[(b * 64 + g) * 64 + p] = hr; out_im[(b * 64 + g) * 64 + p] = hm; }
    __syncthreads();
}
__device__ __forceinline__ void carry_sample_item(int item, const float* E16, const float* A16, const float* h0r, const float* h0i, bf16* HS, float* out_re, float* out_im, int lane) {
    const int b = item >> 6, g = item & 63, p = lane;
    const float ar = A16[(g * 64 + p) * 2], ai = A16[(g * 64 + p) * 2 + 1];
    const int j0 = MP / 16 + b * 4;
    const float* ep = E16 + ((size_t)j0 * 64 + g) * 128 + p; bf16* hp = HS + ((size_t)j0 * 64 + g) * 128 + p;
    float hr = h0r[(b * 64 + g) * 64 + p], hm = h0i[(b * 64 + g) * 64 + p];
#pragma unroll
    for (int j = 0; j < 4; ++j) { hp[(size_t)j * 8192] = (bf16)f2bf(hr); hp[(size_t)j * 8192 + 64] = (bf16)f2bf(hm);
        const float xr = ep[(size_t)j * 8192], xi = ep[(size_t)j * 8192 + 64]; const float nr = ar * hr - ai * hm + xr, ni = ar * hm + ai * hr + xi; hr = nr; hm = ni; }
    out_re[(b * 64 + g) * 64 + p] = hr; out_im[(b * 64 + g) * 64 + p] = hm;
}

__device__ __forceinline__ void store_kb(bf16* kp, float c) {
    const float val = -c * SQRT_HD; const unsigned h0 = f2bf(val); const float r1 = val - bf2f(h0); const unsigned h1 = f2bf(r1); const float r2 = r1 - bf2f(h1); const unsigned h2 = f2bf(r2);
    v4u a; a.x = h0 | (h1 << 16); a.y = h2; a.z = 0u; a.w = 0u; v4u z = {0u, 0u, 0u, 0u};
    *(GAS v4u*)kp = a; *(GAS v4u*)(kp + 8) = z;
}
__device__ __forceinline__ void cumsum_prompt_item(int item, const float* LOGF, bf16* KBP, int* JLO, float ub2t, LAS float* scr, int tid, int wave, int lane) {
    const int b = item >> 3, h = item & 7;
    const float* lp = LOGF + ((size_t)(b * P_SEQ + tid * 16)) * 8 + h;
    float v[16];
#pragma unroll
    for (int i = 0; i < 16; ++i) v[i] = lp[i * 8];
    float run = 0.f;
#pragma unroll
    for (int i = 0; i < 16; ++i) { run += v[i]; v[i] = run; }
    float x = run;
#pragma unroll
    for (int o = 1; o < 64; o <<= 1) { const float y = __shfl_up(x, o); if (lane >= o) x += y; }
    if (lane == 63) scr[wave] = x;
    LDS_WAIT(); __syncthreads();
    float base = x - run;
    for (int w = 0; w < wave; ++w) base += scr[w];
    bf16* kp = KBP + ((size_t)item * P_SEQ + tid * 16) * 16;
#pragma unroll
    for (int i = 0; i < 16; ++i) store_kb(kp + i * 16, base + v[i]);
    if ((tid & 3) == 3) scr[16 + (tid >> 2)] = base + v[15];
    if ((tid & 15) == 0) scr[144 + (tid >> 4)] = base + v[0];
    LDS_WAIT(); __syncthreads();
    if (tid < 32) { const float lim = scr[144 + tid] + ub2t; int j = 0; while (j < 4 * tid && scr[16 + j] > lim) ++j; JLO[item * 32 + tid] = j; }
    __syncthreads();
}
__device__ __forceinline__ void cumsum_sample_item(int item, const float* cache_logf  , const float* LOGF, bf16* KBS, int* TLO, float ub2t, int lane) {
    const int b = item >> 3, h = item & 7;
    float v[17]; float run = 0.f;
#pragma unroll
    for (int i = 0; i < 17; ++i) { const int s = lane * 17 + i; const float x = (s < PAST) ? cache_logf[((size_t)b * PAST + s) * 8 + h] : LOGF[((size_t)(MP + b * S_SEQ + s - PAST)) * 8 + h]; run += x; v[i] = run; }
    float x = run;
#pragma unroll
    for (int o = 1; o < 64; o <<= 1) { const float y = __shfl_up(x, o); if (lane >= o) x += y; }
    const float base = x - run;
    bf16* kp = KBS + ((size_t)item * (PAST + S_SEQ) + lane * 17) * 16;
#pragma unroll
    for (int i = 0; i < 17; ++i) store_kb(kp + i * 16, base + v[i]);
    const float lim = __shfl(base + v[4], 60) + ub2t; int tl = 0;
#pragma unroll
    for (int i = 0; i < 17; ++i) { const int s = lane * 17 + i; if ((s & 63) == 63 && s < PAST && base + v[i] > lim) tl = (s >> 6) + 1; }
#pragma unroll
    for (int o = 1; o < 64; o <<= 1) tl = max(tl, __shfl_xor(tl, o));
    if (lane == 0) TLO[item] = tl;
}

__device__ __forceinline__ void sc_item(int item, const bf16* U, const bf16* HS, const bf16* BC, bf16* ZS, int lane) {
    const int nq = item & 1, t2 = item >> 1, jb = t2 % 36, g = t2 / 36, r32 = lane & 31, hi = lane >> 5, j = jb * 32 + r32;
    const bf16* bu = U + ((size_t)g * MROWS + (size_t)j * 16) * 16 + 8 * hi;
    const bf16* bh = HS + ((size_t)j * 64 + g) * 128 + 8 * hi;
    const bf16* ap = BC + ((size_t)(g * 256 + nq * 128 + r32)) * 384 + 8 * hi;
    f32x16 acc0 = {}, acc1 = {}, acc2 = {}, acc3 = {};
#pragma unroll 4
    for (int s = 0; s < 16; ++s) { const bf16x8 b = *(const bf16x8*)(bu + 16 * s);
        const bf16x8 a0 = *(const bf16x8*)(ap + 16 * s), a1 = *(const bf16x8*)(ap + 32 * 384 + 16 * s), a2 = *(const bf16x8*)(ap + 64 * 384 + 16 * s), a3 = *(const bf16x8*)(ap + 96 * 384 + 16 * s);
        acc0 = MFMA32(a0, b, acc0); acc1 = MFMA32(a1, b, acc1); acc2 = MFMA32(a2, b, acc2); acc3 = MFMA32(a3, b, acc3); }
#pragma unroll 4
    for (int s = 0; s < 8; ++s) { const bf16x8 b = *(const bf16x8*)(bh + 16 * s); const bf16* aq = ap + 256 + 16 * s;
        const bf16x8 a0 = *(const bf16x8*)(aq), a1 = *(const bf16x8*)(aq + 32 * 384), a2 = *(const bf16x8*)(aq + 64 * 384), a3 = *(const bf16x8*)(aq + 96 * 384);
        acc0 = MFMA32(a0, b, acc0); acc1 = MFMA32(a1, b, acc1); acc2 = MFMA32(a2, b, acc2); acc3 = MFMA32(a3, b, acc3); }
#define SC_STORE(ACC, nb) do { _Pragma("unroll") for (int rq = 0; rq < 4; ++rq) { const int n0 = nq * 128 + (nb) * 32 + 8 * rq + 4 * hi; const int t = n0 >> 4, c0 = n0 & 15; \
        const pg8::f32x2 ga = pg8::gelu_pk((pg8::f32x2){ACC[4 * rq], ACC[4 * rq + 1]}), gb = pg8::gelu_pk((pg8::f32x2){ACC[4 * rq + 2], ACC[4 * rq + 3]}); \
        v2u w; w.x = pg8::cvt_pk_bf16(ga.x, ga.y); w.y = pg8::cvt_pk_bf16(gb.x, gb.y); *(GAS v2u*)(ZS + (size_t)(16 * j + t) * 1024 + g * 16 + c0) = w; } } while (0)
    SC_STORE(acc0, 0); SC_STORE(acc1, 1); SC_STORE(acc2, 2); SC_STORE(acc3, 3);
#undef SC_STORE
}

__device__ __forceinline__ float sumsq8(v4u a) { float s = 0.f;
    s += bf2f(a.x & 0xffffu) * bf2f(a.x & 0xffffu) + __uint_as_float(a.x & 0xffff0000u) * __uint_as_float(a.x & 0xffff0000u);
    s += bf2f(a.y & 0xffffu) * bf2f(a.y & 0xffffu) + __uint_as_float(a.y & 0xffff0000u) * __uint_as_float(a.y & 0xffff0000u);
    s += bf2f(a.z & 0xffffu) * bf2f(a.z & 0xffffu) + __uint_as_float(a.z & 0xffff0000u) * __uint_as_float(a.z & 0xffff0000u);
    s += bf2f(a.w & 0xffffu) * bf2f(a.w & 0xffffu) + __uint_as_float(a.w & 0xffff0000u) * __uint_as_float(a.w & 0xffff0000u);
    return s; }
__device__ __forceinline__ unsigned scale2(unsigned w, float s) { return pk2(bf2f(w & 0xffffu) * s, __uint_as_float(w & 0xffff0000u) * s); }
__device__ __forceinline__ v4u scale8(v4u a, float s) { v4u o; o.x = scale2(a.x, s); o.y = scale2(a.y, s); o.z = scale2(a.z, s); o.w = scale2(a.w, s); return o; }
__device__ __forceinline__ void norm_row_item(bf16* yrow, int lane) {
    GAS v4u* p = (GAS v4u*)yrow + lane;
    const v4u a0 = p[0], a1 = p[64], b0 = p[128], b1 = p[192];
    const float ss = wave_sum(sumsq8(a0) + sumsq8(a1)), sa = wave_sum(sumsq8(b0) + sumsq8(b1));
    const float rs = rsqrtf(ss * (1.0f / 1024.0f) + EPS), ra = rsqrtf(sa * (1.0f / 1024.0f) + EPS);
    p[0] = scale8(a0, rs); p[64] = scale8(a1, rs); p[128] = scale8(b0, ra); p[192] = scale8(b1, ra);
}

namespace fox {
constexpr int NW = 8, QBLK = 32, KVBLK = 64, QB = NW * QBLK, D = 128, PITCH = 1024;
constexpr int SHM_V = KVBLK * D * 2, SHM_K = KVBLK * D * 2;
constexpr int LDS_ATT = 2 * SHM_V + 2 * SHM_K + NW * 64 * 4;
constexpr float SCALE = 0.08838834764831845f, THR = 8.f;
typedef short s16x4 __attribute__((ext_vector_type(4)));
#define KSWZ(row, colB) ((row) * 256 + ((colB) ^ (((row) & 7) << 4)))
#define SBAR() __builtin_amdgcn_sched_barrier(0)
__device__ __forceinline__ int v_st(int k, int c) { const int kk = (k & ~0xC) | ((k & 4) << 1) | ((k & 8) >> 1); return ((kk >> 3) * 4 + (c >> 5)) * 512 + ((kk & 7) * 32 + (c & 31)) * 2; }
__device__ __forceinline__ int v_rd_base(int lane) { return ((lane & 3) << 3) | (((lane >> 2) & 3) << 6) | (((lane >> 4) & 1) << 5) | (((lane >> 5) & 1) << 8); }
constexpr int v_rd_off(int d0, int ks, int half) { return d0 * 512 + ks * 4096 + half * 2048; }
__device__ __forceinline__ unsigned cvtpk(float lo, float hi) { unsigned r; asm volatile("v_cvt_pk_bf16_f32 %0, %1, %2" : "=v"(r) : "v"(lo), "v"(hi)); return r; }
__device__ __forceinline__ bf16x8 pack8(f32x4 a, f32x4 b) { v4u w = {cvtpk(a[0], a[1]), cvtpk(a[2], a[3]), cvtpk(b[0], b[1]), cvtpk(b[2], b[3])}; return *reinterpret_cast<bf16x8*>(&w); }
__device__ __forceinline__ bf16x8 ld8(const bf16* p) { return *reinterpret_cast<const bf16x8*>(p); }
__device__ __forceinline__ void mask_tile(f32x16& p0, f32x16& p1, int dq) {
    const float NEG = -__builtin_inff();
#pragma unroll
    for (int r = 0; r < 16; ++r) { const int c = (r & 3) + 8 * (r >> 2); if (dq - c < 0) p0[r] = NEG; if (dq - c - 32 < 0) p1[r] = NEG; }
}
__device__ __forceinline__ void partialSM(f32x16& p0, f32x16& p1, float& m_reg, float& mn, float& alpha) {
    float pmax = p0[0];
#pragma unroll
    for (int r = 1; r < 16; ++r) pmax = fmaxf(pmax, p0[r]);
#pragma unroll
    for (int r = 0; r < 16; ++r) pmax = fmaxf(pmax, p1[r]);
    { auto rr = __builtin_amdgcn_permlane32_swap(__float_as_uint(pmax), __float_as_uint(pmax), false, false); pmax = fmaxf(__uint_as_float(rr[0]), __uint_as_float(rr[1])); }
    constexpr float C2 = 1.4426950408889634f * SCALE;
    if (__builtin_expect(__all((pmax - m_reg) * SCALE <= THR), 1)) { mn = m_reg; alpha = 1.f; }
    else { mn = fmaxf(m_reg, pmax); alpha = __builtin_amdgcn_exp2f((m_reg - mn) * C2); m_reg = mn; }
    const float mnL = -mn * C2;
#pragma unroll
    for (int r = 0; r < 16; ++r) p0[r] = fmaf(p0[r], C2, mnL);
#pragma unroll
    for (int r = 0; r < 16; ++r) p1[r] = fmaf(p1[r], C2, mnL);
#pragma unroll
    for (int r = 0; r < 16; ++r) p0[r] = __builtin_amdgcn_exp2f(p0[r]);
}
__device__ __forceinline__ void finishSM(f32x16& p0, f32x16& p1, float alpha, float& l_reg, bf16x8& pa0, bf16x8& pa1, bf16x8& pa2, bf16x8& pa3) {
#pragma unroll
    for (int r = 0; r < 16; ++r) p1[r] = __builtin_amdgcn_exp2f(p1[r]);
    float ps = 0;
#pragma unroll
    for (int r = 0; r < 16; ++r) ps += p0[r];
#pragma unroll
    for (int r = 0; r < 16; ++r) ps += p1[r];
    { auto rr = __builtin_amdgcn_permlane32_swap(__float_as_uint(ps), __float_as_uint(ps), false, false); ps = __uint_as_float(rr[0]) + __uint_as_float(rr[1]); }
    l_reg = l_reg * alpha + ps;
#define PK4(P, B_, OUT) do { unsigned a0 = cvtpk(P[B_+0], P[B_+1]), a1 = cvtpk(P[B_+2], P[B_+3]); unsigned b0 = cvtpk(P[B_+4], P[B_+5]), b1 = cvtpk(P[B_+6], P[B_+7]); \
        auto r0 = __builtin_amdgcn_permlane32_swap(a0, b0, false, false); auto r1 = __builtin_amdgcn_permlane32_swap(a1, b1, false, false); \
        v4u w = {r0[0], r1[0], r0[1], r1[1]}; OUT = *reinterpret_cast<bf16x8*>(&w); } while (0)
    PK4(p0, 0, pa0); PK4(p0, 8, pa1); PK4(p1, 0, pa2); PK4(p1, 8, pa3);
#undef PK4
}
__device__ __forceinline__ void qkt(f32x16& p0, f32x16& p1, const char* Kt, int r32, int hi, const bf16x8* qr, const bf16* kbp, bf16x8 qone) {
    const bf16x8 kb0 = ld8(kbp), kb1 = ld8(kbp + 32 * 16);
    p0 = f32x16{}; p1 = f32x16{};
    const char* kb[4];
#pragma unroll
    for (int dd = 0; dd < 4; ++dd) kb[dd] = Kt + KSWZ(r32, (dd * 16 + hi * 8) * 2);
#pragma unroll
    for (int d0 = 0; d0 < 8; ++d0) { const char* a = kb[d0 & 3] + (d0 >> 2) * 128;
        bf16x8 b0 = *reinterpret_cast<const bf16x8*>(a); bf16x8 b1 = *reinterpret_cast<const bf16x8*>(a + 32 * 256);
        p0 = MFMA32(b0, qr[d0], p0); p1 = MFMA32(b1, qr[d0], p1); }
    p0 = MFMA32(kb0, qone, p0); p1 = MFMA32(kb1, qone, p1);
}
template <int VOFF>
__device__ __forceinline__ void pv_tile(f32x16* o, int vb0, bf16x8 pa0, bf16x8 pa1, bf16x8 pa2, bf16x8 pa3) {
#define TRRD(dst, off) asm volatile("ds_read_b64_tr_b16 %0, %1 offset:%2" : "=&v"(dst) : "v"(vb0), "i"(off) : "memory")
#define PV_D0(d0) do { s16x4 l0, l1, l2, l3, h0, h1, h2, h3; constexpr int b_ = VOFF + v_rd_off(d0, 0, 0); \
        TRRD(l0, b_); TRRD(h0, b_ + 2048); TRRD(l1, b_ + 4096); TRRD(h1, b_ + 6144); TRRD(l2, b_ + 8192); TRRD(h2, b_ + 10240); TRRD(l3, b_ + 12288); TRRD(h3, b_ + 14336); \
        asm volatile("s_waitcnt lgkmcnt(0)" ::: "memory"); SBAR(); \
        o[d0] = MFMA32(pa0, ((bf16x8){l0[0], l0[1], l0[2], l0[3], h0[0], h0[1], h0[2], h0[3]}), o[d0]); \
        o[d0] = MFMA32(pa1, ((bf16x8){l1[0], l1[1], l1[2], l1[3], h1[0], h1[1], h1[2], h1[3]}), o[d0]); \
        o[d0] = MFMA32(pa2, ((bf16x8){l2[0], l2[1], l2[2], l2[3], h2[0], h2[1], h2[2], h2[3]}), o[d0]); \
        o[d0] = MFMA32(pa3, ((bf16x8){l3[0], l3[1], l3[2], l3[3], h3[0], h3[1], h3[2], h3[3]}), o[d0]); } while (0)
    PV_D0(0); PV_D0(1); PV_D0(2); PV_D0(3);
#undef PV_D0
#undef TRRD
}
__device__ __forceinline__ void store_o(const f32x16* o, const float* li_l, const bf16* SZw, bf16* Ow, int r32, int hi) {
    float rli[16];
#pragma unroll
    for (int r = 0; r < 16; ++r) rli[r] = __builtin_amdgcn_rcpf(li_l[crow(r, hi)]);
#pragma unroll
    for (int r = 0; r < 16; ++r) { const int orow = crow(r, hi);
#pragma unroll
        for (int d0 = 0; d0 < 4; ++d0) { const float z = bf2f(SZw[(size_t)orow * PITCH + d0 * 32 + r32]); const float v = o[d0][r] * rli[r] * z;
            const float vn = __shfl_xor(v, 1);
            if ((r32 & 1) == 0) *(unsigned*)(Ow + (size_t)orow * 2048 + d0 * 32 + r32) = cvtpk(v, vn); } }
}

struct BlockRef { const bf16* Q; const bf16* K; const bf16* V; const bf16* KB; const bf16* SZ; bf16* O; int P0; int jlo; };
struct Seam { bf16x8 qr[8]; bf16x8 st_v0, st_v1, st_k0, st_k1; };
#define ROW(p, k0, rr) ((p) + (unsigned)(((k0) + (rr)) * PITCH + sc))
#define VMW() asm volatile("s_waitcnt vmcnt(0)" ::: "memory")
#define VMWN(n) asm volatile("s_waitcnt vmcnt(%0)" :: "i"(n) : "memory")
#define SLOAD_H(Kp, Vp, k0) do { S.st_v0 = ld8(ROW(Vp, k0, sr)); S.st_v1 = ld8(ROW(Vp, k0, 32 + sr)); S.st_k0 = ld8(ROW(Kp, k0, sr)); S.st_k1 = ld8(ROW(Kp, k0, 32 + sr)); } while (0)
#define SWRITE_HK(bf) do { *(bf16x8*)(K_lds + (bf) * SHM_K + kws) = S.st_k0; *(bf16x8*)(K_lds + (bf) * SHM_K + kws + 32 * 256) = S.st_k1; } while (0)
#define SWRITE_HV(bf) do { *(bf16x8*)(V_lds + (bf) * SHM_V + vst0) = S.st_v0; *(bf16x8*)(V_lds + (bf) * SHM_V + vst1) = S.st_v1; } while (0)
#define SWRITE_H(bf) do { SWRITE_HV(bf); SWRITE_HK(bf); } while (0)
__device__ __forceinline__ void fox_prime(const BlockRef& cur, char* lds, Seam& S) {
    int tid_ = threadIdx.x; asm volatile("" : "+v"(tid_));
    const int tid = tid_, wid = __builtin_amdgcn_readfirstlane(tid >> 6), lane = tid & 63, r32 = lane & 31, hi = lane >> 5;
    const int sr = tid >> 4, sc = (tid & 15) * 8, kws = KSWZ(sr, sc * 2); char* K_lds = lds + 2 * SHM_V;
#pragma unroll
    for (int d0 = 0; d0 < 8; ++d0) S.qr[d0] = ld8(cur.Q + (size_t)(wid * QBLK + r32) * PITCH + d0 * 16 + hi * 8);
    SLOAD_H(cur.K, cur.V, cur.jlo * KVBLK); VMW(); SWRITE_HK(0);
    __syncthreads();
}
__device__ __forceinline__ void fox_block(const BlockRef& cur, const BlockRef& nxt, char* lds, Seam& S, bf16x8 qone) {
    int tid_ = threadIdx.x; asm volatile("" : "+v"(tid_));
    const int tid = tid_, wid = __builtin_amdgcn_readfirstlane(tid >> 6), lane = tid & 63, r32 = lane & 31, hi = lane >> 5;
    const int j_lo = cur.jlo, NT = (cur.P0 + QB - 1) / KVBLK + 1 - j_lo;
    const int kbn = nxt.jlo * KVBLK;
    const int qlo = cur.P0 + wid * QBLK, qm = qlo + r32 - 4 * hi;
    char* V_lds = lds; char* K_lds = lds + 2 * SHM_V;
    float* ws = (float*)(lds + 2 * SHM_V + 2 * SHM_K) + wid * 64; float* li_l = ws, * al_l = ws + 32;
    float m_reg = -1e30f, l_reg = 0; f32x16 o[4] = {};
    const int sr = tid >> 4, sc = (tid & 15) * 8, vst0 = v_st(sr, sc), vst1 = v_st(32 + sr, sc), kws = KSWZ(sr, sc * 2);
    const int vb0 = (int)(uintptr_t)V_lds + v_rd_base(lane);
    const bf16* Kh = cur.K; const bf16* Vh = cur.V; const bf16* KBh = cur.KB; const unsigned kbl = (unsigned)(r32 * 16 + hi * 8);
#define RESC(a) do { if (__any((a) < 1.f)) { if (hi == 0) al_l[r32] = (a); asm volatile("s_waitcnt lgkmcnt(0)" ::: "memory"); \
                     _Pragma("unroll") for (int d_ = 0; d_ < 4; ++d_) _Pragma("unroll") for (int r = 0; r < 16; ++r) o[d_][r] *= al_l[crow(r, hi)]; } } while (0)
#define KBASE(t) ((j_lo + (t)) * KVBLK)
#define MASKT(P0_, P1_, t) do { const int kb_ = KBASE(t); if (kb_ + KVBLK - 1 > qlo) mask_tile(P0_, P1_, qm - kb_); } while (0)
    constexpr int NQL = 8;
#define SEAM_K0() do { VMWN(NQL); SWRITE_HK(0); SBAR(); } while (0)
    f32x16 pA0, pA1, pB0, pB1; float mnA, mnB, alA, alB; bf16x8 pa0, pa1, pa2, pa3;
    SWRITE_HV(0); SBAR();
    if (NT > 1) SLOAD_H(Kh, Vh, KBASE(1));
    SBAR(); qkt(pA0, pA1, K_lds, r32, hi, S.qr, KBh + (kbl + (unsigned)KBASE(0) * 16u), qone);
    MASKT(pA0, pA1, 0); partialSM(pA0, pA1, m_reg, mnA, alA);
    if (NT > 1) { VMW(); SWRITE_H(1); }
    __syncthreads();
#define HALF_STEP(PX0, PX1, mnX, alX, PY0, PY1, alY, t, KBI, VBI, SBI) do { \
        SBAR(); qkt(PX0, PX1, K_lds + (KBI) * SHM_K, r32, hi, S.qr, KBh + (kbl + (unsigned)KBASE(t) * 16u), qone); \
        finishSM(PY0, PY1, alY, l_reg, pa0, pa1, pa2, pa3); SBAR(); \
        if ((t) + 1 < NT) { SLOAD_H(Kh, Vh, KBASE((t) + 1)); SBAR(); } \
        pv_tile<(VBI) * SHM_V>(o, vb0, pa0, pa1, pa2, pa3); MASKT(PX0, PX1, (t)); partialSM(PX0, PX1, m_reg, mnX, alX); \
        __syncthreads(); \
        if ((t) + 1 < NT) { VMW(); SWRITE_H(SBI); } \
        RESC(alX); __syncthreads(); } while (0)
    for (int t = 1; t + 1 < NT; t += 2) {
        HALF_STEP(pB0, pB1, mnB, alB, pA0, pA1, alA, t, 1, 0, 0);
        HALF_STEP(pA0, pA1, mnA, alA, pB0, pB1, alB, t + 1, 0, 1, 1);
    }
    const bool even = (NT & 1) == 0;
    if (even) { SBAR(); qkt(pB0, pB1, K_lds + SHM_K, r32, hi, S.qr, KBh + (kbl + (unsigned)KBASE(NT - 1) * 16u), qone); SBAR(); }
    SLOAD_H(nxt.K, nxt.V, kbn); SBAR();
#pragma unroll
    for (int d0 = 0; d0 < 8; ++d0) S.qr[d0] = ld8(nxt.Q + (size_t)(wid * QBLK + r32) * PITCH + d0 * 16 + hi * 8);
    SBAR();
    finishSM(pA0, pA1, alA, l_reg, pa0, pa1, pa2, pa3); SBAR();
    pv_tile<0>(o, vb0, pa0, pa1, pa2, pa3);
    if (even) { MASKT(pB0, pB1, NT - 1); partialSM(pB0, pB1, m_reg, mnB, alB); __syncthreads(); RESC(alB);
        finishSM(pB0, pB1, alB, l_reg, pa0, pa1, pa2, pa3); SBAR(); pv_tile<SHM_V>(o, vb0, pa0, pa1, pa2, pa3); }
    SBAR(); SEAM_K0();
    if (hi == 0) li_l[r32] = l_reg; asm volatile("s_waitcnt lgkmcnt(0)" ::: "memory");
    store_o(o, li_l, cur.SZ + (size_t)(wid * QBLK) * PITCH, cur.O + (size_t)(wid * QBLK) * 2048, r32, hi);
    __syncthreads();
#undef RESC
#undef KBASE
#undef MASKT
#undef SEAM_K0
#undef HALF_STEP
}
__device__ __forceinline__ BlockRef prompt_ref(int bh, int qb, const bf16* Qb, const bf16* Kb, const bf16* Vb, const bf16* KBP, const bf16* SZA, bf16* YN, const int* JLO) {
    const int b = bh >> 3, h = bh & 7; const size_t row0 = (size_t)b * P_SEQ + (size_t)qb * QB; BlockRef r;
    r.Q = Qb + row0 * PITCH + h * D; r.K = Kb + (size_t)b * P_SEQ * PITCH + h * D; r.V = Vb + (size_t)b * P_SEQ * PITCH + h * D; r.KB = KBP + (size_t)bh * P_SEQ * 16;
    r.SZ = SZA + row0 * PITCH + h * D; r.O = YN + row0 * 2048 + 1024 + h * D; r.P0 = qb * QB; r.jlo = JLO[bh * 32 + qb]; return r;
}
__device__ __forceinline__ void prompt_attn(int first, int G, const bf16* Qb, const bf16* Kb, const bf16* Vb, const bf16* KBP, const bf16* SZA, bf16* YN, const int* JLO, char* lds, bf16x8 qone) {
    int L = first; if (L >= 256) return;
    Seam S; int pass = 0; BlockRef cur = prompt_ref(L >> 4, L & 15, Qb, Kb, Vb, KBP, SZA, YN, JLO);
    fox_prime(cur, lds, S);
    for (;;) {
        const bool more_pass = pass == 0, more_item = L + G < 256, last = !more_pass && !more_item;
        int Ln = L, passn = pass + 1; if (!more_pass) { passn = 0; Ln = more_item ? L + G : L; }
        const int yn = Ln & 15; const BlockRef nxt = last ? cur : prompt_ref(Ln >> 4, passn ? 31 - yn : yn, Qb, Kb, Vb, KBP, SZA, YN, JLO);
        fox_block(cur, nxt, lds, S, qone);
        if (last) break;
        cur = nxt; pass = passn; L = Ln;
    }
}

__device__ __forceinline__ void fox_sample_unit(int b, int h, int tlo, const float* cK, const float* cV, const bf16* Kb, const bf16* Vb, const bf16* Qb, const bf16* KBS, const bf16* SZA, bf16* YN, char* lds, bf16x8 qone) {
    int tid_ = threadIdx.x; asm volatile("" : "+v"(tid_));
    const int tid = tid_, wid = __builtin_amdgcn_readfirstlane(tid >> 6), lane = tid & 63, r32 = lane & 31, hi = lane >> 5;
    const int sr = tid >> 4, sc = (tid & 15) * 8, vst0 = v_st(sr, sc), vst1 = v_st(32 + sr, sc), kws = KSWZ(sr, sc * 2);
    char* V_lds = lds; char* K_lds = lds + 2 * SHM_V;
    float* ws = (float*)(lds + 2 * SHM_V + 2 * SHM_K) + wid * 64; float* li_l = ws, * al_l = ws + 32;
    const int vb0 = (int)(uintptr_t)V_lds + v_rd_base(lane);
    const size_t rowq = (size_t)MP + (size_t)b * S_SEQ;
    const float* ck = cK + ((size_t)b * PAST) * 1024 + h * D + sc; const float* cv = cV + ((size_t)b * PAST) * 1024 + h * D + sc;
    const bf16* nk = Kb + rowq * PITCH + h * D + sc; const bf16* nv = Vb + rowq * PITCH + h * D + sc;
    const bf16* kbp = KBS + ((size_t)(b * 8 + h) * (PAST + S_SEQ) + r32) * 16 + hi * 8;
    const int wq = wid & 1;
    bf16x8 qr[8];
#pragma unroll
    for (int d0 = 0; d0 < 8; ++d0) qr[d0] = ld8(Qb + (rowq + wq * 32 + r32) * PITCH + h * D + d0 * 16 + hi * 8);
    float m_reg = -1e30f, l_reg = 0; f32x16 o[4] = {};
    f32x4 kf0, kf1, kf2, kf3, vf0, vf1, vf2, vf3;
#define LOADF(t) do { const float* kp_ = ck + (size_t)((t) * KVBLK + sr) * 1024; const float* vp_ = cv + (size_t)((t) * KVBLK + sr) * 1024; \
        kf0 = *(const f32x4*)kp_; kf1 = *(const f32x4*)(kp_ + 4); kf2 = *(const f32x4*)(kp_ + 32 * 1024); kf3 = *(const f32x4*)(kp_ + 32 * 1024 + 4); \
        vf0 = *(const f32x4*)vp_; vf1 = *(const f32x4*)(vp_ + 4); vf2 = *(const f32x4*)(vp_ + 32 * 1024); vf3 = *(const f32x4*)(vp_ + 32 * 1024 + 4); } while (0)
#define WRITEF(bf) do { *(bf16x8*)(K_lds + (bf) * SHM_K + kws) = pack8(kf0, kf1); *(bf16x8*)(K_lds + (bf) * SHM_K + kws + 32 * 256) = pack8(kf2, kf3); \
        *(bf16x8*)(V_lds + (bf) * SHM_V + vst0) = pack8(vf0, vf1); *(bf16x8*)(V_lds + (bf) * SHM_V + vst1) = pack8(vf2, vf3); } while (0)
#define LOADH() do { kf0 = *(const f32x4*)(nk + (size_t)sr * PITCH); kf1 = *(const f32x4*)(nk + (size_t)(32 + sr) * PITCH); vf0 = *(const f32x4*)(nv + (size_t)sr * PITCH); vf1 = *(const f32x4*)(nv + (size_t)(32 + sr) * PITCH); } while (0)
#define WRITEH(bf) do { *(f32x4*)(K_lds + (bf) * SHM_K + kws) = kf0; *(f32x4*)(K_lds + (bf) * SHM_K + kws + 32 * 256) = kf1; \
        *(f32x4*)(V_lds + (bf) * SHM_V + vst0) = vf0; *(f32x4*)(V_lds + (bf) * SHM_V + vst1) = vf1; } while (0)
#define RESC(a) do { if (__any((a) < 1.f)) { if (hi == 0) al_l[r32] = (a); asm volatile("s_waitcnt lgkmcnt(0)" ::: "memory"); \
                     _Pragma("unroll") for (int d_ = 0; d_ < 4; ++d_) _Pragma("unroll") for (int r = 0; r < 16; ++r) o[d_][r] *= al_l[crow(r, hi)]; } } while (0)
    constexpr int NTS = PAST / KVBLK + 1;
    const int t0 = (tlo < 14 ? tlo : 14) & ~1;
    LOADF(t0);
    VMW(); WRITEF(0); __syncthreads();
#pragma unroll 1
    for (int t = t0; t < NTS; t += 2) {
#define SSTEP(tt, BUF) do { \
        if ((tt) + 1 < NTS - 1) { LOADF((tt) + 1); } else if ((tt) + 1 == NTS - 1) { LOADH(); } \
        if (wid < 2) { f32x16 p0, p1; float mn, al; bf16x8 pa0, pa1, pa2, pa3; \
            qkt(p0, p1, K_lds + (BUF) * SHM_K, r32, hi, qr, kbp + (size_t)((tt) * KVBLK) * 16, qone); \
            if ((tt) == NTS - 1) mask_tile(p0, p1, wid * QBLK + r32 - 4 * hi); \
            partialSM(p0, p1, m_reg, mn, al); RESC(al); finishSM(p0, p1, al, l_reg, pa0, pa1, pa2, pa3); SBAR(); \
            pv_tile<(BUF) * SHM_V>(o, vb0, pa0, pa1, pa2, pa3); } \
        if ((tt) + 1 < NTS) { VMW(); if ((tt) + 1 < NTS - 1) { WRITEF((BUF) ^ 1); } else { WRITEH((BUF) ^ 1); } } \
        __syncthreads(); } while (0)
        SSTEP(t, 0);
        if (t + 1 < NTS) SSTEP(t + 1, 1);
#undef SSTEP
    }
    if (wid < 2) { if (hi == 0) li_l[r32] = l_reg; asm volatile("s_waitcnt lgkmcnt(0)" ::: "memory");
        store_o(o, li_l, SZA + (rowq + wid * QBLK) * PITCH + h * D, YN + (rowq + wid * QBLK) * 2048 + 1024 + h * D, r32, hi); }
    __syncthreads();
#undef LOADF
#undef WRITEF
#undef LOADH
#undef WRITEH
#undef RESC
}
#undef ROW
#undef VMW
#undef VMWN
#undef SLOAD_H
#undef SWRITE_HK
#undef SWRITE_HV
#undef SWRITE_H
#undef KSWZ
#undef SBAR
}
#define STAGE_B_PHASES \
          \
        if (IN(ph + 3)) { PHASE_PTRS; const bf16* BCl = (const bf16*)(ws + WS_BC) + (size_t)l * 64 * 256 * 384; \
            for (int rep_ = 0; rep_ < 1 + DUP_S5; ++rep_) for (int it = gw; it < 64 * 36 * 2; it += NGW) sc_item(it, Ub, HS, BCl, ZS, lane); } \
        SEAM(ph + 3); \
          \
        if (IN(ph + 4)) { PHASE_PTRS; \
            pg8::Gemm g{ZS, (const bf16*)(ws + WS_WGLU) + (size_t)l * 1024 * 1024, MROWS, 1024, 1024}; pg8::StaticOrder S; S.init(MROWS, 1024, G, (int)blockIdx.x); \
            pg8::EpiGlu E{ws, inp[21] + l * 1024}; \
            for (int rep_ = 0; rep_ < 1 + DUP_GLU; ++rep_) pg8::gemm_phase<pg8::EpiGlu, pg8::StaticOrder, true, true>(lds + RING_OFF, g, S, E); \
        } \
        SEAM(ph + 4); \
          \
        if (IN(ph + 5)) { PHASE_PTRS; \
            bf16x8 qone = {0, 0, 0, 0, 0, 0, 0, 0}; if ((tid & 32) == 0) { qone[0] = (short)0x3F80; qone[1] = (short)0x3F80; qone[2] = (short)0x3F80; } \
            for (int rep_ = 0; rep_ < 1 + DUP_AS; ++rep_) for (int u = vcu; u < 256; u += G) fox::fox_sample_unit(u >> 3, u & 7, ((const int*)(ws + WS_JLO + 2048))[u], inp[2] + (size_t)l * 32 * PAST * 1024, inp[3] + (size_t)l * 32 * PAST * 1024, Kb, Vb, Qb, KBS, SZA, YN, (char*)lds_raw, qone); \
            fox::prompt_attn(vcu, G, Qb, Kb, Vb, KBP, SZA, YN, (const int*)(ws + WS_JLO), (char*)lds_raw, qone); \
            if (DUP_AP) { int v2_ = vcu; asm volatile("" : "+s"(v2_)); fox::prompt_attn(v2_, G, Qb, Kb, Vb, KBP, SZA, YN, (const int*)(ws + WS_JLO), (char*)lds_raw, qone); } \
        } \
        SEAM(ph + 5); \
          \
        if (IN(ph + 6)) { PHASE_PTRS; for (int rep_ = 0; rep_ < 1 + DUP_NORM; ++rep_) for (int m = gw; m < MROWS; m += NGW) norm_row_item(YN + (size_t)m * 2048, lane); } \
        SEAM(ph + 6); \
          \
        if (IN(ph + 7)) { PHASE_PTRS; \
            pg8::Gemm g{YN, (const bf16*)(ws + WS_WOUT) + (size_t)l * 2048 * 2048, MROWS, 2048, 2048}; pg8::StaticOrder S; S.init(MROWS, 2048, G, (int)blockIdx.x); \
            pg8::EpiOut E{l == 0 ? inp[0] : (const float*)out, l == 0 ? inp[1] : (const float*)(out + O_YS), out, ws, l}; \
            pg8::gemm_phase<pg8::EpiOut, pg8::StaticOrder, true, true>(lds + RING_OFF, g, S, E); \
        } \
        SEAM(ph + 7); \


constexpr int PH_PER_LAYER = 8, N_PHASES = 1 + DEPTH * PH_PER_LAYER;

struct Args { const float* in[25]; float* out; unsigned char* ws; int ph_lo, ph_hi; };
__global__ void __launch_bounds__(NWAVES * 64, 2) fwd_kernel(Args args) {
    extern __shared__ __attribute__((aligned(16))) unsigned char lds_raw[];
    LAS unsigned char* lds = (LAS unsigned char*)lds_raw;
    const int tid0 = threadIdx.x;
    const int G = gridDim.x; const int bx = blockIdx.x; const int vcu = (G % 8 == 0) ? (bx % 8) * (G / 8) + bx / 8 : bx;
    unsigned* ctl = (unsigned*)(args.ws + WS_CTL);
    volatile LAS unsigned* MISC = (volatile LAS unsigned*)(lds + MISC_OFF);
    if (tid0 < 32) MISC[tid0] = 0u;
    __syncthreads();
    const int lo = args.ph_lo, hi = args.ph_hi;
    const bool multi = (hi - lo) > 1;
    XcdBarrier bar; bar.bar = ctl + CW_BAR; bar.x = 0; bar.st = nullptr;
    if (multi) bar = xcd_barrier_post(ctl + CW_BAR, MISC + 8);
#define IN(k) (lo <= (k) && (k) < hi)
#define SEAM(k) do { if (IN(k) && IN((k) + 1)) xcd_barrier(bar); } while (0)
#define PHASE_PTRS int z_ = 0; int tid = tid0; asm volatile("" : "+s"(z_), "+v"(tid)); const int lane = tid & 63, wave = __builtin_amdgcn_readfirstlane(tid >> 6), gw = vcu * NWAVES + wave, NGW = G * NWAVES; (void)lane; (void)gw; (void)NGW; const float* const* inp = args.in + z_; unsigned char* ws = args.ws + z_; float* out = args.out + z_; float* rowsq = (float*)(ws + WS_CTL) + CW_ROWSQ; (void)inp; (void)out; (void)rowsq
#define XB ((bf16*)(ws + WS_XB))
#define Ub ((bf16*)(ws + WS_U))
#define SZS ((bf16*)(ws + WS_SZS))
#define Qb ((bf16*)(ws + WS_Q))
#define Kb ((bf16*)(ws + WS_K))
#define Vb ((bf16*)(ws + WS_V))
#define SZA ((bf16*)(ws + WS_SZA))
#define ZS ((bf16*)(ws + WS_ZS))
#define YN ((bf16*)(ws + WS_YN))
#define E16 ((float*)(ws + WS_E16))
#define HS ((bf16*)(ws + WS_HS))
#define LOGF ((float*)(ws + WS_LOGF))
#define KBP ((bf16*)(ws + WS_KBP))
#define KBS ((bf16*)(ws + WS_KBS))

    if (IN(0)) { PHASE_PTRS; p0_prologue(inp, ws, lds, tid, wave, lane, vcu, G); if (DUP_P0) { __syncthreads(); int v2_ = vcu; asm volatile("" : "+s"(v2_)); p0_prologue(inp, ws, lds, tid, wave, lane, v2_, G); } }
    SEAM(0);

    for (int l = 0; l < N_LAYERS_RUN; ++l) {
        const int ph = 1 + l * PH_PER_LAYER;
        if (IN(ph + 0)) { PHASE_PTRS;
            pg8::Gemm g{XB, (const bf16*)(ws + WS_WIN) + (size_t)l * N_IN * 2048, MROWS, N_IN, 2048}; pg8::StaticOrder S; S.init(MROWS, N_IN, G, (int)blockIdx.x);
            pg8::EpiIn E{ws, out, inp[10] + l * 128, inp[11] + l * 128, l, (LAS float*)(lds + RED_OFF)};
            for (int rep_ = 0; rep_ < 1 + DUP_IN; ++rep_) pg8::gemm_phase<pg8::EpiIn, pg8::StaticOrder, true, true>(lds + RING_OFF, g, S, E);
        }
        SEAM(ph + 0);
        if (IN(ph + 1)) { PHASE_PTRS;
            const bf16* WTl = (const bf16*)(ws + WS_WT) + (size_t)l * 64 * 128 * 256;
            for (int rep_ = 0; rep_ < 1 + DUP_S5; ++rep_)
            for (int it = gw; it < 64 * 36 * 2; it += NGW) e16_item(it, Ub, WTl, E16, lane);
            for (int rep_ = 0; rep_ < 1 + DUP_S5; ++rep_)
            for (int it = gw; it < MROWS / 16; it += NGW) fpre_item(it, XB, (const bf16*)(ws + WS_WF) + (size_t)l * 16 * 2048, rowsq + (size_t)l * MROWS, inp[9] + l * 8, LOGF,
                                                                out + O_LFP + (size_t)l * MP * 8, out + O_LFS + (size_t)l * MS * 8, lane);
        }
        SEAM(ph + 1);
        if (IN(ph + 2)) { PHASE_PTRS;
            const float* A16l = (const float*)(ws + WS_A16) + (size_t)l * 64 * 64 * 2;
            for (int rep_ = 0; rep_ < 1 + DUP_S5; ++rep_) {
            for (int it = vcu; it < 128 + 16; it += G) {
                if (it < 128) carry_prompt_item(it, E16, A16l, HS, out + O_HRP + (size_t)l * 2 * 64 * 64, out + O_HIP + (size_t)l * 2 * 64 * 64, (LAS float*)(lds + RING_OFF), wave, lane);
                else cumsum_prompt_item(it - 128, LOGF, KBP, (int*)(ws + WS_JLO), 2.0f * ((const float*)(ws + WS_UB))[l] + ACP_T, (LAS float*)(lds + RING_OFF), tid, wave, lane);
            }
            for (int it = gw; it < 2048 + 256; it += NGW) {
                if (it < 2048) carry_sample_item(it, E16, A16l, inp[5] + (size_t)l * 32 * 64 * 64, inp[6] + (size_t)l * 32 * 64 * 64, HS, out + O_HRS + (size_t)l * 32 * 64 * 64, out + O_HIS + (size_t)l * 32 * 64 * 64, lane);
                else cumsum_sample_item(it - 2048, inp[4] + (size_t)l * 32 * PAST * 8, LOGF, KBS, (int*)(ws + WS_JLO + 2048), 2.0f * ((const float*)(ws + WS_UB))[l] + ACP_T, lane);
            } }
        }
        SEAM(ph + 2);
        STAGE_B_PHASES
    }
#undef IN
#undef SEAM
}

extern "C" void kernel_launch(void* const* d_in, const int* in_sizes, int n_in, void* d_out, int out_size, void* d_ws, size_t ws_size, hipStream_t stream) {
    static int grid = 0;
    if (grid == 0) {
        if (n_in != 25 || (size_t)out_size != O_END || ws_size < WS_END) { fprintf(stderr, "kernel_launch: unexpected shapes (n_in %d out %d ws %zu, need ws %zu)\n", n_in, out_size, ws_size, (size_t)WS_END); grid = -1; return; }
        int dev = 0, cus = 0, per_cu = 0;
        if (hipGetDevice(&dev) != hipSuccess || hipDeviceGetAttribute(&cus, hipDeviceAttributeMultiprocessorCount, dev) != hipSuccess) { grid = -1; return; }
        if (hipFuncSetAttribute((const void*)fwd_kernel, hipFuncAttributeMaxDynamicSharedMemorySize, LDS_BYTES) != hipSuccess) { fprintf(stderr, "kernel_launch: hipFuncSetAttribute failed\n"); grid = -1; return; }
        if (hipOccupancyMaxActiveBlocksPerMultiprocessor(&per_cu, (const void*)fwd_kernel, NWAVES * 64, LDS_BYTES) != hipSuccess || per_cu < 1) { fprintf(stderr, "kernel_launch: occupancy query says %d\n", per_cu); }
        (void)hipGetLastError();
        grid = cus;
    }
    if (grid < 0) return;
    if (hipMemsetAsync((char*)d_ws + WS_CTL, 0, CTL_ZERO_BYTES, stream) != hipSuccess) return;
#if STAGE_ZERO_OUT
    (void)hipMemsetAsync(d_out, 0, (size_t)out_size * 4, stream);
#endif
    Args a{};
    for (int i = 0; i < 25; ++i) a.in[i] = (const float*)d_in[i];
    a.out = (float*)d_out; a.ws = (unsigned char*)d_ws;
#if ONE_LAUNCH
    a.ph_lo = 0; a.ph_hi = N_PHASES;
    hipLaunchKernelGGL(fwd_kernel, dim3(grid), dim3(NWAVES * 64), LDS_BYTES, stream, a);
#else
    for (int p = 0; p < N_PHASES; ++p) { a.ph_lo = p; a.ph_hi = p + 1; hipLaunchKernelGGL(fwd_kernel, dim3(grid), dim3(NWAVES * 64), LDS_BYTES, stream, a); }
#endif
}
```

```cpp
#include <hip/hip_runtime.h>
#include <cstdio>
#include <cstdint>

constexpr int D_MODEL = 2048, DEPTH = 4, N_HEADS = 8, HEAD_DIM = 128, N_GROUPS = 64, STATE_DIM = 64, SSM_GROUP = 16;
constexpr int P_BATCH = 2, P_SEQ = 8192, S_BATCH = 32, S_SEQ = 64, PAST = 1024;
constexpr int MP = P_BATCH * P_SEQ;
constexpr int MS = S_BATCH * S_SEQ;
constexpr int MROWS = MP + MS;
constexpr int D_HALF = 1024, D_PROJ = 6152, N_IN = 6144;
constexpr int NSUB = MROWS / 16;
constexpr float EPS = 1e-6f;
constexpr float SQRT_HD = 11.313708498984761f;

constexpr size_t MiB = 1u << 20;
constexpr size_t WS_CTL = 0, CTL_ZERO_BYTES = 2 * MiB;
constexpr size_t WS_A16  = 2 * MiB;
constexpr size_t WS_WF   = 3 * MiB;
constexpr size_t WS_WIN  = 4 * MiB;
constexpr size_t WS_WGLU = WS_WIN + 4ull * N_IN * 2048 * 2;
constexpr size_t WS_WOUT = WS_WGLU + 4ull * 1024 * 1024 * 2;
constexpr size_t WS_WT   = WS_WOUT + 4ull * 2048 * 2048 * 2;
constexpr size_t WS_BC   = WS_WT + 4ull * 64 * 128 * 256 * 2;
constexpr size_t WS_XB   = WS_BC + 4ull * 64 * 256 * 384 * 2;
constexpr size_t WS_U    = WS_XB + (size_t)MROWS * 2048 * 2;
constexpr size_t WS_SZS  = WS_U + (size_t)MROWS * 1024 * 2;
constexpr size_t WS_Q    = WS_SZS + (size_t)MROWS * 1024 * 2;
constexpr size_t WS_K    = WS_Q + (size_t)MROWS * 1024 * 2;
constexpr size_t WS_V    = WS_K + (size_t)MROWS * 1024 * 2;
constexpr size_t WS_SZA  = WS_V + (size_t)MROWS * 1024 * 2;
constexpr size_t WS_ZS   = WS_SZA + (size_t)MROWS * 1024 * 2;
constexpr size_t WS_YN   = WS_ZS + (size_t)MROWS * 1024 * 2;
constexpr size_t WS_E16  = WS_YN + (size_t)MROWS * 2048 * 2;
constexpr size_t WS_HS   = WS_E16 + (size_t)NSUB * 64 * 128 * 4;
constexpr size_t WS_LOGF = WS_HS + (size_t)NSUB * 64 * 128 * 2;
constexpr size_t WS_KBP  = WS_LOGF + (size_t)MROWS * 8 * 4;
constexpr size_t WS_KBS  = WS_KBP + 16ull * 8192 * 16 * 2;
constexpr size_t WS_JLO  = WS_KBS + 256ull * 1088 * 16 * 2;
constexpr size_t WS_UB   = WS_JLO + 4096;
constexpr size_t WS_END  = WS_UB + 4096;
constexpr float ACP_T = 30.0f;
constexpr int CW_BAR = 4096;
constexpr int CW_ROWSQ = 65536;
static_assert((CW_ROWSQ + 5 * MROWS) * 4 <= (int)CTL_ZERO_BYTES, "CTL words inside the memset region");

constexpr size_t O_YP = 0, O_YS = O_YP + (size_t)MP * 2048, O_KP = O_YS + (size_t)MS * 2048, O_VP = O_KP + 4ull * MP * 1024, O_LFP = O_VP + 4ull * MP * 1024,
                 O_HRP = O_LFP + 4ull * MP * 8, O_HIP = O_HRP + 4ull * 2 * 64 * 64, O_KS = O_HIP + 4ull * 2 * 64 * 64, O_VS = O_KS + 4ull * MS * 1024, O_LFS = O_VS + 4ull * MS * 1024,
                 O_HRS = O_LFS + 4ull * MS * 8, O_HIS = O_HRS + 4ull * 32 * 64 * 64, O_END = O_HIS + 4ull * 32 * 64 * 64;
static_assert(O_END == 190447616ull, "output size");

#ifndef N_LAYERS_RUN
#define N_LAYERS_RUN 4
#endif
#define STAGE_ZERO_OUT 0
#ifndef DUP_IN
#define DUP_IN 0
#endif
#ifndef DUP_S5
#define DUP_S5 0
#endif
#ifndef DUP_GLU
#define DUP_GLU 0
#endif
#ifndef DUP_AS
#define DUP_AS 0
#endif
#ifndef DUP_AP
#define DUP_AP 0
#endif
#ifndef DUP_P0
#define DUP_P0 0
#endif
#ifndef DUP_NORM
#define DUP_NORM 0
#endif
#ifndef DUP_OUT
#define DUP_OUT 0
#endif
#ifndef DUP_BAR
#define DUP_BAR 0
#endif
#ifndef DUP_INN
#define DUP_INN 0
#endif
#ifndef DUP_INO
#define DUP_INO 0
#endif
#ifndef DUP_S5A
#define DUP_S5A 0
#endif
#ifndef DUP_S5B
#define DUP_S5B 0
#endif
#ifndef DUP_S5C
#define DUP_S5C 0
#endif
#ifndef DUP_S5F
#define DUP_S5F 0
#endif
#ifndef ONE_LAUNCH
#define ONE_LAUNCH 1
#endif
namespace pg8 {
#define PG8_LAS __attribute__((address_space(3)))
typedef unsigned short bf16_t;
typedef short bf16x8 __attribute__((ext_vector_type(8)));
typedef float f32x4 __attribute__((ext_vector_type(4)));
typedef unsigned u32x4 __attribute__((ext_vector_type(4)));
constexpr int BM = 256, BK = 64, HALF = 128, HTB = HALF * BK * 2  , STAGE_BYTES = 8 * HTB, NXCD = 8, WGM = 8;

__host__ __device__ __forceinline__ int lds_byte(int r, int c) { const int st = (r >> 4) * 2 + (c >> 5), rr = r & 15, cc = c & 31, ob = rr * 64 + cc * 2; return st * 1024 + (ob ^ (((ob >> 9) & 1) << 5)); }
__host__ __device__ __forceinline__ void stage_rc(int b, int& R, int& C) { const int st = b / 1024, sb = b % 1024, swz = sb ^ (((sb >> 9) & 1) << 5); R = (st >> 1) * 16 + swz / 64; C = (st & 1) * 32 + (swz % 64) / 2; }
__host__ __device__ __forceinline__ int perm32(int rho) { const int n = rho >> 4, i = rho & 15; return 8 * (i >> 2) + 4 * n + (i & 3); }

struct Unit { int pm, pn; };
struct Gemm { const bf16_t* A; const bf16_t* Bt; int M, N, K; };

struct StaticOrder {
    int nM, nN, nwg, G, c;
    __host__ __device__ void init(int M, int N, int G_, int c_) { nM = M / BM; nN = N / BM; nwg = nM * nN; G = G_; c = c_; }
    __host__ __device__ bool next(int i, Unit& u) const {
        const long L = (long)i * G + c; if (L >= nwg) return false;
        int wgid = (int)L; { const int q = nwg / NXCD, r = nwg % NXCD, xcd = wgid % NXCD, off = wgid / NXCD; wgid = (xcd < r ? xcd * (q + 1) : r * (q + 1) + (xcd - r) * q) + off; }
        const int nig = WGM * nN, gid = wgid / nig, fm = gid * WGM, gsz = (nM - fm) < WGM ? (nM - fm) : WGM;
        u.pm = fm + ((wgid % nig) % gsz); u.pn = (wgid % nig) / gsz; return true;
    }
    __device__ __forceinline__ void a_ready(const Unit&) const {}
    __device__ __forceinline__ void done(const Unit&) const {}
};

__device__ __forceinline__ unsigned cvt_pk_bf16(float lo, float hi) { unsigned r; asm volatile("v_cvt_pk_bf16_f32 %0, %1, %2" : "=v"(r) : "v"(lo), "v"(hi)); return r; }
typedef float f32x2 __attribute__((ext_vector_type(2)));
__device__ __forceinline__ f32x2 gelu_pk(f32x2 v) {
    const f32x2 av = __builtin_elementwise_abs(v), d = av * 0.2316418882f + 1.0f;
    f32x2 t; t.x = __builtin_amdgcn_rcpf(d.x); t.y = __builtin_amdgcn_rcpf(d.y);
    f32x2 q = t * 0.5307027145f + (-0.7265760135f); q = q * t + 0.7107068705f; q = q * t + (-0.142248368f); q = q * t + 0.127414796f; q = q * t;
    const f32x2 s = (v * v) * (-0.72134752044f);
    f32x2 e; e.x = __builtin_amdgcn_exp2f(s.x); e.y = __builtin_amdgcn_exp2f(s.y);
    const f32x2 m = v * (q * e), r = v - m;
    f32x2 o; o.x = v.x < 0.f ? m.x : r.x; o.y = v.y < 0.f ? m.y : r.y; return o;
}

__device__ __forceinline__ float bf_lo(unsigned w) { return __uint_as_float(w << 16); }
__device__ __forceinline__ float bf_hi(unsigned w) { return __uint_as_float(w & 0xffff0000u); }
__device__ __forceinline__ float fast_sigmoid(float v) { return __builtin_amdgcn_rcpf(1.0f + __builtin_amdgcn_exp2f(-1.4426950408889634f * v)); }
__device__ __forceinline__ u32x4 pack8f(const f32x4 a, const f32x4 b) { u32x4 w; w.x = cvt_pk_bf16(a[0], a[1]); w.y = cvt_pk_bf16(a[2], a[3]); w.z = cvt_pk_bf16(b[0], b[1]); w.w = cvt_pk_bf16(b[2], b[3]); return w; }

struct EpiIn {
    static constexpr bool PERM = true, AFTER_DRAIN = false;
    unsigned char* ws; float* out; const float *qg, *kg; int l;
    PG8_LAS float* red;
    __device__ __forceinline__ void operator()(const f32x4 (&acc)[2][2][4][2], const Unit& u, int wr, int wc, int fr, int fq) const {
        const float* rowsq = (const float*)(ws + WS_CTL) + CW_ROWSQ + (size_t)l * MROWS;
        bf16_t* U = (bf16_t*)(ws + WS_U); bf16_t* SZS = (bf16_t*)(ws + WS_SZS); bf16_t* Q = (bf16_t*)(ws + WS_Q); bf16_t* K = (bf16_t*)(ws + WS_K); bf16_t* V = (bf16_t*)(ws + WS_V); bf16_t* SZA = (bf16_t*)(ws + WS_SZA);
        float* kout_p = out + O_KP + (size_t)l * MP * 1024; float* kout_s = out + O_KS + (size_t)l * MS * 1024; float* vout_p = out + O_VP + (size_t)l * MP * 1024; float* vout_s = out + O_VS + (size_t)l * MS * 1024;
        const int region = u.pn >> 2, ct = (u.pn & 3) * 256;
        const int rt = wr * 64 + fr, row0 = u.pm * BM + rt, cw = wc * 32 + 8 * fq;
        float rs[2][4];
#pragma unroll
        for (int ai = 0; ai < 2; ++ai)
#pragma unroll
            for (int m = 0; m < 4; ++m) rs[ai][m] = rsqrtf(rowsq[row0 + ai * HALF + m * 16] * (1.0f / 2048.0f) + EPS);
        if (region == 0) {
#pragma unroll
            for (int ai = 0; ai < 2; ++ai)
#pragma unroll
                for (int m = 0; m < 4; ++m) { const int row = row0 + ai * HALF + m * 16; const float s = rs[ai][m];
#pragma unroll
                    for (int bj = 0; bj < 2; ++bj) { const int col = ct + bj * HALF + cw; const int g = col >> 4, c0 = col & 15;
                        *(u32x4*)(U + ((size_t)g * MROWS + row) * 16 + c0) = pack8f(acc[ai][bj][m][0] * s, acc[ai][bj][m][1] * s); } }
        } else if (region == 1 || region == 5) {
            bf16_t* dst = region == 1 ? SZS : SZA;
#pragma unroll
            for (int ai = 0; ai < 2; ++ai)
#pragma unroll
                for (int m = 0; m < 4; ++m) { const int row = row0 + ai * HALF + m * 16; const float s = rs[ai][m];
#pragma unroll
                    for (int bj = 0; bj < 2; ++bj) { f32x4 a = acc[ai][bj][m][0] * s, b = acc[ai][bj][m][1] * s;
#pragma unroll
                        for (int i = 0; i < 4; ++i) { a[i] = a[i] * fast_sigmoid(a[i]); b[i] = b[i] * fast_sigmoid(b[i]); }
                        *(u32x4*)(dst + (size_t)row * 1024 + ct + bj * HALF + cw) = pack8f(a, b); } }
        } else if (region == 4) {
            float* vo = (u.pm < MP / BM) ? vout_p + (size_t)row0 * 1024 : vout_s + (size_t)(row0 - MP) * 1024;
#pragma unroll
            for (int ai = 0; ai < 2; ++ai)
#pragma unroll
                for (int m = 0; m < 4; ++m) { const int ro = ai * HALF + m * 16; const float s = rs[ai][m];
#pragma unroll
                    for (int bj = 0; bj < 2; ++bj) { const f32x4 a = acc[ai][bj][m][0] * s, b = acc[ai][bj][m][1] * s; const int col = ct + bj * HALF + cw;
                        *(u32x4*)(V + (size_t)(row0 + ro) * 1024 + col) = pack8f(a, b);
                        *(f32x4*)(vo + (size_t)ro * 1024 + col) = a; *(f32x4*)(vo + (size_t)ro * 1024 + col + 4) = b; } }
        } else {
#pragma unroll
            for (int ai = 0; ai < 2; ++ai)
#pragma unroll
                for (int m = 0; m < 4; ++m) { const float s = rs[ai][m];
#pragma unroll
                    for (int bj = 0; bj < 2; ++bj) { const f32x4 a = acc[ai][bj][m][0] * s, b = acc[ai][bj][m][1] * s;
                        float q = (a[0] * a[0] + a[1] * a[1]) + (a[2] * a[2] + a[3] * a[3]) + (b[0] * b[0] + b[1] * b[1]) + (b[2] * b[2] + b[3] * b[3]);
                        q += __shfl_xor(q, 16); q += __shfl_xor(q, 32);
                        if (fq == 0) red[((ai * HALF + wr * 64 + m * 16 + fr) * 2 + bj) * 4 + wc] = q; } }
            asm volatile("s_waitcnt lgkmcnt(0)" ::: "memory"); __builtin_amdgcn_s_barrier(); asm volatile("" ::: "memory");
            const float* gp = (region == 2 ? qg : kg) + cw;
            const f32x4 g0 = *(const f32x4*)gp, g1 = *(const f32x4*)(gp + 4);
            bf16_t* dst = region == 2 ? Q : K;
            float* ko = (u.pm < MP / BM) ? kout_p + (size_t)row0 * 1024 : kout_s + (size_t)(row0 - MP) * 1024;
#pragma unroll
            for (int ai = 0; ai < 2; ++ai)
#pragma unroll
                for (int m = 0; m < 4; ++m) { const int ro = ai * HALF + m * 16;
#pragma unroll
                    for (int bj = 0; bj < 2; ++bj) { const f32x4 t = *(const PG8_LAS f32x4*)(red + ((ai * HALF + wr * 64 + m * 16 + fr) * 2 + bj) * 4);
                        const float sc = rsqrtf(((t[0] + t[1]) + (t[2] + t[3])) * (1.0f / 128.0f) + EPS) * rs[ai][m];
                        const f32x4 a = acc[ai][bj][m][0] * sc * g0, b = acc[ai][bj][m][1] * sc * g1; const int col = ct + bj * HALF + cw;
                        *(u32x4*)(dst + (size_t)(row0 + ro) * 1024 + col) = pack8f(a, b);
                        if (region == 3) { *(f32x4*)(ko + (size_t)ro * 1024 + col) = a; *(f32x4*)(ko + (size_t)ro * 1024 + col + 4) = b; } } }
        }
    }
};

struct EpiGlu {
    static constexpr bool PERM = true, AFTER_DRAIN = false;
    unsigned char* ws; const float* bias;
    __device__ __forceinline__ void operator()(const f32x4 (&acc)[2][2][4][2], const Unit& u, int wr, int wc, int fr, int fq) const {
        const bf16_t* ZS = (const bf16_t*)(ws + WS_ZS); const bf16_t* SZS = (const bf16_t*)(ws + WS_SZS); bf16_t* YN = (bf16_t*)(ws + WS_YN);
        const int row0 = u.pm * BM + wr * 64 + fr, c0 = u.pn * BM + wc * 32 + 8 * fq;
#pragma unroll
        for (int bj = 0; bj < 2; ++bj) { const int col = c0 + bj * HALF; const f32x4 b0 = *(const f32x4*)(bias + col), b1 = *(const f32x4*)(bias + col + 4);
#pragma unroll
            for (int ai = 0; ai < 2; ++ai)
#pragma unroll
                for (int m = 0; m < 4; ++m) { const size_t row = (size_t)(row0 + ai * HALF + m * 16);
                    const u32x4 z = *(const u32x4*)(ZS + row * 1024 + col), s = *(const u32x4*)(SZS + row * 1024 + col);
                    const f32x4 v0 = acc[ai][bj][m][0] + b0, v1 = acc[ai][bj][m][1] + b1; f32x4 o0, o1;
                    o0[0] = bf_lo(z.x) * fast_sigmoid(v0[0]) * bf_lo(s.x); o0[1] = bf_hi(z.x) * fast_sigmoid(v0[1]) * bf_hi(s.x);
                    o0[2] = bf_lo(z.y) * fast_sigmoid(v0[2]) * bf_lo(s.y); o0[3] = bf_hi(z.y) * fast_sigmoid(v0[3]) * bf_hi(s.y);
                    o1[0] = bf_lo(z.z) * fast_sigmoid(v1[0]) * bf_lo(s.z); o1[1] = bf_hi(z.z) * fast_sigmoid(v1[1]) * bf_hi(s.z);
                    o1[2] = bf_lo(z.w) * fast_sigmoid(v1[2]) * bf_lo(s.w); o1[3] = bf_hi(z.w) * fast_sigmoid(v1[3]) * bf_hi(s.w);
                    *(u32x4*)(YN + row * 2048 + col) = pack8f(o0, o1); } }
    }
};

struct EpiOut {
    static constexpr bool PERM = true, AFTER_DRAIN = false;
    const float* xin_p; const float* xin_s; float* xout; unsigned char* ws; int l;
    __device__ __forceinline__ void operator()(const f32x4 (&acc)[2][2][4][2], const Unit& u, int wr, int wc, int fr, int fq) const {
        bf16_t* XB = (bf16_t*)(ws + WS_XB); float* rowsq_next = (float*)(ws + WS_CTL) + CW_ROWSQ + (size_t)(l + 1) * MROWS;
        const int row0 = u.pm * BM + wr * 64 + fr, c0 = u.pn * BM + wc * 32 + 8 * fq;
        const float* xi = (u.pm < MP / BM) ? xin_p + (size_t)row0 * 2048 : xin_s + (size_t)(row0 - MP) * 2048;
#pragma unroll
        for (int ai = 0; ai < 2; ++ai)
#pragma unroll
            for (int m = 0; m < 4; ++m) { const int ro = ai * HALF + m * 16; float ss = 0.f;
#pragma unroll
                for (int bj = 0; bj < 2; ++bj) { const int col = c0 + bj * HALF;
                    const f32x4 a = *(const f32x4*)(xi + (size_t)ro * 2048 + col) + acc[ai][bj][m][0], b = *(const f32x4*)(xi + (size_t)ro * 2048 + col + 4) + acc[ai][bj][m][1];
                    *(f32x4*)(xout + (size_t)(row0 + ro) * 2048 + col) = a; *(f32x4*)(xout + (size_t)(row0 + ro) * 2048 + col + 4) = b;
                    *(u32x4*)(XB + (size_t)(row0 + ro) * 2048 + col) = pack8f(a, b);
                    ss += (a[0] * a[0] + a[1] * a[1]) + (a[2] * a[2] + a[3] * a[3]) + (b[0] * b[0] + b[1] * b[1]) + (b[2] * b[2] + b[3] * b[3]); }
                ss += __shfl_xor(ss, 16); ss += __shfl_xor(ss, 32);
                if (fq == 0) unsafeAtomicAdd(rowsq_next + row0 + ro, ss); }
    }
};

struct EpiNull {
    static constexpr bool PERM = true, AFTER_DRAIN = false;
    __device__ __forceinline__ void operator()(const f32x4 (&acc)[2][2][4][2], const Unit& u, int wr, int wc, int fr, int fq) const {
#pragma unroll
        for (int ai = 0; ai < 2; ++ai)
#pragma unroll
            for (int bj = 0; bj < 2; ++bj)
#pragma unroll
                for (int m = 0; m < 4; ++m) { f32x4 a = acc[ai][bj][m][0], b = acc[ai][bj][m][1]; asm volatile("" :: "v"(a), "v"(b)); }
    }
};

struct GluOrder {
    int v, G;
    __device__ __forceinline__ bool next(int i, Unit& u) const {
        int L;
        if (G == 256) { if (i == 0) L = v; else if (i == 1 && (v & 15) < 2) L = 256 + (v >> 4) * 2 + (v & 15); else return false; }
        else { L = i * G + v; if (L >= 288) return false; }
        u.pm = L >> 2; u.pn = L & 3; return true;
    }
    __device__ __forceinline__ void a_ready(const Unit&) const {}
    __device__ __forceinline__ void done(const Unit&) const {}
};
template <class Epi, class Sched, bool ALIGN_EPI = false, bool SP2 = false>
__device__ __forceinline__ void gemm_phase(PG8_LAS unsigned char* lds, const Gemm g, const Sched& S, const Epi& E) {
    int tid_ = threadIdx.x; asm volatile("" : "+v"(tid_));
    const int tid = tid_, wid = __builtin_amdgcn_readfirstlane(tid >> 6), lane = tid & 63, wr = wid >> 2, wc = wid & 3, fr = lane & 15, fq = lane >> 4;
    const int K = g.K, nt = K / BK;
    unsigned voffA[2], voffB[2];
#pragma unroll
    for (int i = 0; i < 2; ++i) { int R, C; stage_rc(tid * 16 + i * 8192, R, C); const int Rb = Epi::PERM ? ((R & ~31) + perm32(R & 31)) : R;
        voffA[i] = (unsigned)(R * K + C) * 2u; voffB[i] = (unsigned)(Rb * K + C) * 2u; }
    const size_t kstep = (size_t)(BK * 2);
    const size_t hstep = (size_t)HALF * K * 2;
    const size_t tstep = 2 * hstep;
    const unsigned ldsw = (unsigned)wid * 1024u;
    const int aoff = lds_byte(wr * 64 + fr, fq * 8), boff = lds_byte(wc * 32 + fr, fq * 8);
#define PG8_SA(b, h) (((b) * 2 + (h)) * HTB)
#define PG8_SB(b, h) ((4 + (b) * 2 + (h)) * HTB)
#define PG8_STAGE(bufoff, gbase, voff) do { _Pragma("unroll") for (int _i = 0; _i < 2; ++_i) \
        __builtin_amdgcn_global_load_lds((const unsigned*)((const char*)(gbase) + (voff)[_i]), (PG8_LAS unsigned*)(lds + (bufoff) + ldsw + _i * 8192), 16, 0, 0); } while (0)
#define PG8_LDA(dst, b, h) do { _Pragma("unroll") for (int m = 0; m < 4; ++m) _Pragma("unroll") for (int k = 0; k < 2; ++k) dst[m][k] = *(const PG8_LAS bf16x8*)(lds + PG8_SA(b, h) + aoff + m * 2048 + k * 1024); } while (0)
#define PG8_LDB(dst, b, h) do { _Pragma("unroll") for (int n = 0; n < 2; ++n) _Pragma("unroll") for (int k = 0; k < 2; ++k) dst[n][k] = *(const PG8_LAS bf16x8*)(lds + PG8_SB(b, h) + boff + n * 2048 + k * 1024); } while (0)
#define PG8_MMA(ai, bj, At, Bt) do { __builtin_amdgcn_s_setprio(1); _Pragma("unroll") for (int m = 0; m < 4; ++m) _Pragma("unroll") for (int n = 0; n < 2; ++n) _Pragma("unroll") for (int k = 0; k < 2; ++k) \
        acc[ai][bj][m][n] = __builtin_amdgcn_mfma_f32_16x16x32_bf16(Bt[n][k], At[m][k], acc[ai][bj][m][n], 0, 0, 0); __builtin_amdgcn_s_setprio(0); } while (0)
#define PG8_WAIT_V(n) asm volatile("s_waitcnt vmcnt(" #n ")" ::: "memory")
#define PG8_WAIT_L(n) asm volatile("s_waitcnt lgkmcnt(" #n ")" ::: "memory")
#define PG8_BAR __builtin_amdgcn_s_barrier()
#define PG8_SCHED __builtin_amdgcn_sched_barrier(0)
    Unit cur, nxt; int ui = 0;
    if (!S.next(0, cur)) return;
    f32x4 acc[2][2][4][2];
#pragma unroll
    for (int a = 0; a < 2; ++a)
#pragma unroll
        for (int b = 0; b < 2; ++b)
#pragma unroll
            for (int m = 0; m < 4; ++m)
#pragma unroll
                for (int n = 0; n < 2; ++n) acc[a][b][m][n] = (f32x4){0.f, 0.f, 0.f, 0.f};
    bf16x8 At[4][2], B0[2][2], B1[2][2];
    const char* cA = (const char*)g.A + (size_t)cur.pm * tstep; const char* cB = (const char*)g.Bt + (size_t)cur.pn * tstep;
    S.a_ready(cur);
    if constexpr (SP2) {
        PG8_STAGE(PG8_SB(0, 0), cB, voffB); PG8_STAGE(PG8_SB(0, 1), cB + hstep, voffB); PG8_STAGE(PG8_SA(0, 0), cA, voffA); PG8_STAGE(PG8_SA(0, 1), cA + hstep, voffA);
        if (wr == 1) PG8_BAR;
        PG8_WAIT_V(2); PG8_BAR;
        PG8_STAGE(PG8_SB(1, 0), cB + kstep, voffB); PG8_STAGE(PG8_SA(1, 0), cA + kstep, voffA); PG8_STAGE(PG8_SB(1, 1), cB + hstep + kstep, voffB);
        PG8_WAIT_V(6); PG8_BAR;
    } else {
        PG8_STAGE(PG8_SB(0, 0), cB, voffB); PG8_STAGE(PG8_SA(0, 0), cA, voffA); PG8_STAGE(PG8_SB(0, 1), cB + hstep, voffB); PG8_STAGE(PG8_SA(0, 1), cA + hstep, voffA);
        if (wr == 1) PG8_BAR;
        PG8_WAIT_V(4); PG8_BAR;
        PG8_STAGE(PG8_SB(1, 0), cB + kstep, voffB); PG8_STAGE(PG8_SA(1, 0), cA + kstep, voffA); PG8_STAGE(PG8_SB(1, 1), cB + hstep + kstep, voffB);
        PG8_WAIT_V(6); PG8_BAR;
    }
    for (;;) {
        const bool has_next = S.next(ui + 1, nxt);
        const char* nA = has_next ? (const char*)g.A + (size_t)nxt.pm * tstep : cA; const char* nB = has_next ? (const char*)g.Bt + (size_t)nxt.pn * tstep : cB;
        for (int t = 0; t < nt; t += 2) {
            const bool last = (t == nt - 2);
            const char* a1 = cA + (size_t)(t + 1) * kstep;
            const char* a2 = last ? nA : cA + (size_t)(t + 2) * kstep; const char* b2 = last ? nB : cB + (size_t)(t + 2) * kstep;
            const char* a3 = a2 + kstep; const char* b3 = b2 + kstep;
            if (last && has_next) S.a_ready(nxt);
            if constexpr (SP2) {
            PG8_LDB(B0, 0, 0); PG8_LDB(B1, 0, 1); PG8_SCHED; PG8_LDA(At, 0, 0); PG8_STAGE(PG8_SA(1, 1), a1 + hstep, voffA);
            PG8_WAIT_V(8); PG8_WAIT_L(0); PG8_BAR; PG8_MMA(0, 0, At, B0); PG8_MMA(0, 1, At, B1); PG8_BAR; PG8_SCHED;
            PG8_LDA(At, 0, 1); PG8_STAGE(PG8_SB(0, 0), b2, voffB); PG8_STAGE(PG8_SB(0, 1), b2 + hstep, voffB); PG8_STAGE(PG8_SA(0, 0), a2, voffA);
            PG8_WAIT_V(8); PG8_WAIT_L(0); PG8_BAR; PG8_MMA(1, 0, At, B0); PG8_MMA(1, 1, At, B1); PG8_BAR; PG8_SCHED;
            PG8_LDB(B0, 1, 0); PG8_LDB(B1, 1, 1); PG8_SCHED; PG8_LDA(At, 1, 0); PG8_STAGE(PG8_SA(0, 1), a2 + hstep, voffA);
            PG8_WAIT_V(8); PG8_WAIT_L(0); PG8_BAR; PG8_MMA(0, 0, At, B0); PG8_MMA(0, 1, At, B1); PG8_BAR; PG8_SCHED;
            PG8_LDA(At, 1, 1); PG8_STAGE(PG8_SB(1, 0), b3, voffB); PG8_STAGE(PG8_SB(1, 1), b3 + hstep, voffB); PG8_STAGE(PG8_SA(1, 0), a3, voffA);
            PG8_WAIT_V(8); PG8_WAIT_L(0); PG8_BAR; PG8_MMA(1, 0, At, B0); PG8_MMA(1, 1, At, B1); PG8_BAR; PG8_SCHED;
            } else {
            PG8_LDB(B0, 0, 0); PG8_SCHED; PG8_LDA(At, 0, 0); PG8_STAGE(PG8_SA(1, 1), a1 + hstep, voffA);
            PG8_WAIT_L(8); PG8_BAR; PG8_WAIT_L(0); PG8_MMA(0, 0, At, B0); PG8_BAR; PG8_SCHED;
            PG8_LDB(B1, 0, 1); PG8_STAGE(PG8_SB(0, 0), b2, voffB);
            PG8_BAR; PG8_WAIT_L(0); PG8_MMA(0, 1, At, B1); PG8_BAR;
            PG8_LDA(At, 0, 1); PG8_STAGE(PG8_SA(0, 0), a2, voffA);
            PG8_BAR; PG8_WAIT_L(0); PG8_MMA(1, 0, At, B0); PG8_BAR; PG8_SCHED;
            PG8_STAGE(PG8_SB(0, 1), b2 + hstep, voffB);
            PG8_WAIT_V(6); PG8_BAR; PG8_MMA(1, 1, At, B1); PG8_BAR;
            PG8_LDB(B0, 1, 0); PG8_SCHED; PG8_LDA(At, 1, 0); PG8_STAGE(PG8_SA(0, 1), a2 + hstep, voffA);
            PG8_WAIT_L(8); PG8_BAR; PG8_WAIT_L(0); PG8_MMA(0, 0, At, B0); PG8_BAR; PG8_SCHED;
            PG8_LDB(B1, 1, 1); PG8_STAGE(PG8_SB(1, 0), b3, voffB);
            PG8_BAR; PG8_WAIT_L(0); PG8_MMA(0, 1, At, B1); PG8_BAR;
            PG8_LDA(At, 1, 1); PG8_STAGE(PG8_SA(1, 0), a3, voffA);
            PG8_BAR; PG8_WAIT_L(0); PG8_MMA(1, 0, At, B0); PG8_BAR; PG8_SCHED;
            PG8_STAGE(PG8_SB(1, 1), b3 + hstep, voffB);
            PG8_WAIT_V(6); PG8_BAR; PG8_MMA(1, 1, At, B1); PG8_BAR;
            }
        }
        if constexpr (ALIGN_EPI) { if (wr == 0) PG8_BAR; }
        if constexpr (!Epi::AFTER_DRAIN) { E(acc, cur, wr, wc, fr, fq); S.done(cur); }
        if (!has_next) break;
#pragma unroll
        for (int a = 0; a < 2; ++a)
#pragma unroll
            for (int b = 0; b < 2; ++b)
#pragma unroll
                for (int m = 0; m < 4; ++m)
#pragma unroll
                    for (int n = 0; n < 2; ++n) acc[a][b][m][n] = (f32x4){0.f, 0.f, 0.f, 0.f};
        cur = nxt; cA = nA; cB = nB; ++ui;
        if constexpr (ALIGN_EPI) { if (wr == 1) PG8_BAR; }
    }
    PG8_WAIT_V(0);
    if constexpr (!ALIGN_EPI) { if (wr == 0) PG8_BAR; }
    PG8_BAR;
    if constexpr (Epi::AFTER_DRAIN) { E.fused(acc, cur, wr, wc, fr, fq, lds, wid, lane); S.done(cur); }
#undef PG8_SA
#undef PG8_SB
#undef PG8_STAGE
#undef PG8_LDA
#undef PG8_LDB
#undef PG8_MMA
#undef PG8_WAIT_V
#undef PG8_WAIT_L
#undef PG8_BAR
#undef PG8_SCHED
}
}

constexpr int RING_OFF = 0, RING_BYTES = 131072;
constexpr int RED_OFF = RING_BYTES;
constexpr int MISC_OFF = RED_OFF + 8192;
constexpr int LDS_BYTES = 147456;
static_assert(MISC_OFF + 128 <= LDS_BYTES, "LDS map");
constexpr int NWAVES = 8;

#define GAS __attribute__((address_space(1)))
#define LAS __attribute__((address_space(3)))
typedef unsigned short bf16;
typedef unsigned v4u __attribute__((ext_vector_type(4)));
typedef unsigned v2u __attribute__((ext_vector_type(2)));
typedef float f32x4 __attribute__((ext_vector_type(4)));
typedef float f32x16 __attribute__((ext_vector_type(16)));
typedef short bf16x8 __attribute__((ext_vector_type(8)));
#define LDS_WAIT() asm volatile("s_waitcnt lgkmcnt(0)" ::: "memory")
#define VM_WAIT() asm volatile("s_waitcnt vmcnt(0)" ::: "memory")
__device__ __forceinline__ unsigned f2bf(float f) { unsigned u = __builtin_bit_cast(unsigned, f); return (u + 0x7fffu + ((u >> 16) & 1u)) >> 16; }
__device__ __forceinline__ unsigned pk2(float lo, float hi) { return f2bf(lo) | (f2bf(hi) << 16); }
__device__ __forceinline__ float bf2f(unsigned h) { return __uint_as_float(h << 16); }
__device__ __forceinline__ float wave_sum(float v) {
#pragma unroll
    for (int o = 1; o < 64; o <<= 1) v += __shfl_xor(v, o);
    return v;
}
#define XB_TMO      128
#define XB_XCNT(j)  (256  + 64 * (j))
#define XB_XSUB(j)  (1280 + 64 * (j))
#define XB_XGEN(j)  (2304 + 64 * (j))
#define XB_TOP      3328
#define XB_TOPGEN   3392
#define XCD_BAR_WORDS 3456
#define XB_SPIN_CAP (1u << 18)

__device__ __forceinline__ unsigned xb_ld(unsigned* p)              { return __hip_atomic_load(p, __ATOMIC_RELAXED, __HIP_MEMORY_SCOPE_AGENT); }
__device__ __forceinline__ unsigned xb_add(unsigned* p, unsigned v) { return __hip_atomic_fetch_add(p, v, __ATOMIC_RELAXED, __HIP_MEMORY_SCOPE_AGENT); }
__device__ __forceinline__ unsigned xb_xcc_id() { return (unsigned)__builtin_amdgcn_s_getreg((3 << 11) | 20) & 0xFu; }
#define XB_SPIN(cond, bar) do { unsigned _sp = 0; while (cond) { __builtin_amdgcn_s_sleep(1); \
    if ((++_sp & 255u) == 0u) { if (xb_ld(&(bar)[XB_TMO])) break; if (_sp > XB_SPIN_CAP) { atomicAdd(&(bar)[XB_TMO], 1u); break; } } } } while (0)

struct XcdBarrier {
    unsigned* bar; unsigned x;
    volatile LAS unsigned* st;
};

__device__ __forceinline__ XcdBarrier xcd_barrier_post(unsigned* bar, volatile LAS unsigned* st) {
    XcdBarrier b; b.bar = bar; b.x = xb_xcc_id(); b.st = st;
    if (threadIdx.x == 0) (void)xb_add(&bar[XB_XCNT(b.x)], 1u);
    return b;
}
__device__ __forceinline__ void xcd_barrier_complete(unsigned* bar, unsigned x, unsigned& nloc, unsigned& nx) {
    const unsigned G = gridDim.x * gridDim.y * gridDim.z;
    asm volatile("" : "+s"(x));
    unsigned sum, cnt, mine, sp = 0u;
    for (;;) {
        sum = 0u; cnt = 0u; mine = 0u;
#pragma unroll
        for (unsigned j = 0; j < 16; ++j) { const unsigned c = xb_ld(&bar[XB_XCNT(j)]); sum += c; cnt += (c > 0u) ? 1u : 0u; mine = (j == x) ? c : mine; }
        if (sum == G) break;
        __builtin_amdgcn_s_sleep(1);
        if ((++sp & 255u) == 0u) { if (xb_ld(&bar[XB_TMO])) break; if (sp > XB_SPIN_CAP) { atomicAdd(&bar[XB_TMO], 1u); break; } }
    }
    nloc = mine > 0u ? mine : 1u; nx = cnt > 0u ? cnt : 1u;
}

__device__ __forceinline__ void xcd_barrier(const XcdBarrier& b) {
    asm volatile("s_waitcnt vmcnt(0)" ::: "memory");
    __syncthreads();
    if (threadIdx.x == 0) {
        unsigned* bar = b.bar; asm volatile("" : "+s"(bar));
        __builtin_amdgcn_s_waitcnt(0);
        unsigned nloc = b.st[0], nx = b.st[1];
        if (nloc == 0u) { xcd_barrier_complete(bar, b.x, nloc, nx); b.st[0] = nloc; b.st[1] = nx; }
        const unsigned old = xb_add(&bar[XB_XSUB(b.x)], 1u);
        const unsigned gen = old / nloc;
        if (old + 1u == (gen + 1u) * nloc) {
            __builtin_amdgcn_fence(__ATOMIC_RELEASE, "agent");
            asm volatile("s_waitcnt vmcnt(0)" ::: "memory");
            const unsigned og = xb_add(&bar[XB_TOP], 1u);
            const unsigned tg = og / nx;
            if (og + 1u == (tg + 1u) * nx) xb_add(&bar[XB_TOPGEN], 1u);
            else XB_SPIN(xb_ld(&bar[XB_TOPGEN]) == tg, bar);
            __builtin_amdgcn_fence(__ATOMIC_ACQUIRE, "agent");
            xb_add(&bar[XB_XGEN(b.x)], 1u);
            asm volatile("s_waitcnt vmcnt(0)" ::: "memory");
        } else {
            XB_SPIN(xb_ld(&bar[XB_XGEN(b.x)]) == gen, bar);
            __builtin_amdgcn_fence(__ATOMIC_ACQUIRE, "agent");
            asm volatile("s_waitcnt vmcnt(0)" ::: "memory");
        }
    }
    __syncthreads();
}

__device__ __forceinline__ int crow(int r, int hi) { return (r & 3) + 8 * (r >> 2) + 4 * hi; }
#define MFMA32(a, b, c) __builtin_amdgcn_mfma_f32_32x32x16_bf16((a), (b), (c), 0, 0, 0)
#define MFMA16(a, b, c) __builtin_amdgcn_mfma_f32_16x16x32_bf16((a), (b), (c), 0, 0, 0)

__device__ __forceinline__ void dsincos(double x, double& s, double& c) {
    const double k = __builtin_rint(x * 0.63661977236758134308);
    double r = __builtin_fma(-k, 1.57079632679489655800e+00, x); r = __builtin_fma(-k, 6.12323399573676603587e-17, r);
    const double r2 = r * r;
    double sp = -7.6471637318198164759e-13;
    sp = sp * r2 + 1.6059043836821614599e-10; sp = sp * r2 - 2.5052108385441718775e-08; sp = sp * r2 + 2.7557319223985890653e-06;
    sp = sp * r2 - 1.9841269841269841270e-04; sp = sp * r2 + 8.3333333333333333333e-03; sp = sp * r2 - 1.6666666666666666667e-01;
    const double sr = r + r * r2 * sp;
    double cp = 4.7794773323873852974e-14;
    cp = cp * r2 - 1.1470745597729724714e-11; cp = cp * r2 + 2.0876756987868098979e-09; cp = cp * r2 - 2.7557319223985890653e-07;
    cp = cp * r2 + 2.4801587301587301587e-05; cp = cp * r2 - 1.3888888888888888889e-03; cp = cp * r2 + 4.1666666666666666667e-02; cp = cp * r2 - 0.5;
    const double cr = 1.0 + r2 * cp;
    const int q = ((int)k) & 3;
    s = (q == 0) ? sr : (q == 1) ? cr : (q == 2) ? -sr : -cr;
    c = (q == 0) ? cr : (q == 1) ? -sr : (q == 2) ? -cr : sr;
}

__device__ __forceinline__ void p0_transpose_item(const float* W, int ldw, int K, bf16* WT, const float* gain, LAS float* scr, int kb, int nb, int lane) {
    const int k0 = 64 * kb, n0 = 32 * nb;
    f32x4 v[8]; float gn[8];
#pragma unroll
    for (int i = 0; i < 8; ++i) { const int idx = i * 64 + lane, kk = idx >> 3, n4 = idx & 7; v[i] = *(const GAS f32x4*)(W + (size_t)(k0 + kk) * ldw + n0 + 4 * n4); gn[i] = gain ? gain[k0 + kk] : 1.0f; }
#pragma unroll
    for (int i = 0; i < 8; ++i) { const int idx = i * 64 + lane, kk = idx >> 3, n4 = idx & 7; LAS float* d = scr + kk * 33 + 4 * n4;
        d[0] = v[i][0] * gn[i]; d[1] = v[i][1] * gn[i]; d[2] = v[i][2] * gn[i]; d[3] = v[i][3] * gn[i]; }
    LDS_WAIT(); asm volatile("" ::: "memory");
    const int c = lane & 7;
#pragma unroll
    for (int j = 0; j < 4; ++j) { const int n = (lane >> 3) + 8 * j; const LAS float* s = scr + (8 * c) * 33 + n;
        v4u o; o.x = pk2(s[0 * 33], s[1 * 33]); o.y = pk2(s[2 * 33], s[3 * 33]); o.z = pk2(s[4 * 33], s[5 * 33]); o.w = pk2(s[6 * 33], s[7 * 33]);
        *(GAS v4u*)(WT + (size_t)(n0 + n) * K + k0 + 8 * c) = o; }
    LDS_WAIT(); asm volatile("" ::: "memory");
}

__device__ __forceinline__ void p0_s5_item(int l, int g, const float* const* in, bf16* WT, bf16* BC, float* A16, float* UB, LAS float* scr, int tid) {
    LAS float* PWR = scr; LAS float* PWI = scr + 1088; LAS float* BPR = scr + 2176; LAS float* BPI = scr + 3200;
    LAS float* CR = scr + 4224; LAS float* CI = scr + 5248; LAS float* KL = scr + 6272; LAS float* DD = scr + 10368;
    const int lg = l * 64 + g;
    if (tid < 64) {
        const int p = tid;
        const double dt = exp((double)in[12][lg]);
        const double ar = (double)in[13][lg * 64 + p], ai = (double)in[14][lg * 64 + p];
        const double mag = exp(ar * dt); double sn, cs; dsincos(ai * dt, sn, cs);
        const double abr = mag * cs, abi = mag * sn;
        const double den = ar * ar + ai * ai, nr = abr - 1.0, ni = abi;
        const double cfr = (nr * ar + ni * ai) / den, cfi = (ni * ar - nr * ai) / den;
        double pr = 1.0, pi = 0.0;
        for (int n = 0; n <= 16; ++n) { PWR[n * 64 + p] = (float)pr; PWI[n * 64 + p] = (float)pi; const double t = pr * abr - pi * abi; pi = pr * abi + pi * abr; pr = t; }
        A16[(g * 64 + p) * 2] = PWR[16 * 64 + p]; A16[(g * 64 + p) * 2 + 1] = PWI[16 * 64 + p];
        const float* br = in[15] + ((size_t)lg * 64 + p) * 16; const float* bi = in[16] + ((size_t)lg * 64 + p) * 16;
        for (int c = 0; c < 16; ++c) { const double x = br[c], y = bi[c]; BPR[p * 16 + c] = (float)(cfr * x - cfi * y); BPI[p * 16 + c] = (float)(cfr * y + cfi * x); }
    } else {
        for (int i = tid - 64; i < 1024; i += 448) { CR[i] = in[17][(size_t)lg * 1024 + i]; CI[i] = in[18][(size_t)lg * 1024 + i]; }
        if (tid < 80) DD[tid - 64] = in[19][lg * 16 + tid - 64];
        if (g == 0 && tid >= 448) {
            const int i = tid - 448; float mq = fmaxf(fabsf(in[10][l * 128 + i]), fabsf(in[10][l * 128 + 64 + i])), mk = fmaxf(fabsf(in[11][l * 128 + i]), fabsf(in[11][l * 128 + 64 + i]));
#pragma unroll
            for (int o = 1; o < 64; o <<= 1) { mq = fmaxf(mq, __shfl_xor(mq, o)); mk = fmaxf(mk, __shfl_xor(mk, o)); }
            if (i == 0) UB[l] = SQRT_HD * mq * mk * 1.01f; }
    }
    __syncthreads();
    for (int o = tid; o < 4096; o += 512) { const int lag = o >> 8, c = (o >> 4) & 15, cp = o & 15; float a = 0.f;
        for (int p = 0; p < 64; ++p) { const float pr = PWR[lag * 64 + p], pi = PWI[lag * 64 + p], br = BPR[p * 16 + cp], bi = BPI[p * 16 + cp];
            a += CR[c * 64 + p] * (pr * br - pi * bi) - CI[c * 64 + p] * (pr * bi + pi * br); }
        if (lag == 0 && c == cp) a += DD[c];
        KL[o] = a; }
    __syncthreads();
    bf16* bc = BC + (size_t)g * 256 * 384;
    for (int q = tid; q < 12288; q += 512) { const int n = q / 48, k0 = (q % 48) * 8, t = n >> 4, c = n & 15; float v[8];
        if (k0 < 256) { const int s = k0 >> 4, cp0 = k0 & 15;
#pragma unroll
            for (int e = 0; e < 8; ++e) v[e] = (s <= t) ? KL[(t - s) * 256 + c * 16 + cp0 + e] : 0.f;
        } else { const int kk0 = k0 - 256; const bool im = kk0 >= 64; const int p0 = im ? kk0 - 64 : kk0;
#pragma unroll
            for (int e = 0; e < 8; ++e) { const int p = p0 + e; const float cr = CR[c * 64 + p], ci = CI[c * 64 + p], pr = PWR[(t + 1) * 64 + p], pi = PWI[(t + 1) * 64 + p];
                v[e] = im ? -(cr * pi + ci * pr) : (cr * pr - ci * pi); } }
        v4u o; o.x = pk2(v[0], v[1]); o.y = pk2(v[2], v[3]); o.z = pk2(v[4], v[5]); o.w = pk2(v[6], v[7]);
        *(GAS v4u*)(bc + (size_t)n * 384 + k0) = o; }
    bf16* wt = WT + (size_t)g * 128 * 256;
    for (int q = tid; q < 4096; q += 512) { const int n = q >> 5, k0 = (q & 31) * 8, s = k0 >> 4, cp0 = k0 & 15, p = n & 63; const bool im = n >= 64; float v[8];
        const float pr = PWR[(15 - s) * 64 + p], pi = PWI[(15 - s) * 64 + p];
#pragma unroll
        for (int e = 0; e < 8; ++e) { const float br = BPR[p * 16 + cp0 + e], bi = BPI[p * 16 + cp0 + e]; v[e] = im ? (pr * bi + pi * br) : (pr * br - pi * bi); }
        v4u o; o.x = pk2(v[0], v[1]); o.y = pk2(v[2], v[3]); o.z = pk2(v[4], v[5]); o.w = pk2(v[6], v[7]);
        *(GAS v4u*)(wt + (size_t)n * 256 + k0) = o; }
    __syncthreads();
}

__device__ __forceinline__ void p0_row_item(const float* xrow, bf16* orow, float* rsq, int lane) {
    const GAS f32x4* xr = (const GAS f32x4*)xrow + lane; GAS v2u* o8 = (GAS v2u*)orow + lane; float s = 0.f;
#pragma unroll
    for (int j = 0; j < 8; ++j) { const f32x4 v = xr[64 * j]; s += (v[0] * v[0] + v[1] * v[1]) + (v[2] * v[2] + v[3] * v[3]); v2u w; w.x = pk2(v[0], v[1]); w.y = pk2(v[2], v[3]); o8[64 * j] = w; }
    s = wave_sum(s);
    if (lane == 0) *rsq = s;
}

__device__ __forceinline__ void p0_prologue(const float* const* in, unsigned char* ws, LAS unsigned char* lds, int tid, int wave, int lane, int vcu, int G) {
    for (int it = vcu; it < DEPTH * 64; it += G) { const int l = it >> 6, g = it & 63;
        p0_s5_item(l, g, in, (bf16*)(ws + WS_WT) + (size_t)l * 64 * 128 * 256, (bf16*)(ws + WS_BC) + (size_t)l * 64 * 256 * 384, (float*)(ws + WS_A16) + (size_t)l * 64 * 64 * 2, (float*)(ws + WS_UB), (LAS float*)(lds + RING_OFF), tid); }
    LAS float* scr = (LAS float*)(lds + RING_OFF + wave * 16384);
    const int gw = vcu * NWAVES + wave, NGW = G * NWAVES;
    constexpr int I_IN = 32 * 192, I_GLU = 16 * 32, I_OUT = 32 * 64, PER_L = I_IN + I_GLU + I_OUT;
    for (int it = gw; it < DEPTH * PER_L; it += NGW) { const int l = it / PER_L; int r = it - l * PER_L;
        if (r < I_IN) { p0_transpose_item(in[8] + (size_t)l * 2048 * D_PROJ, D_PROJ, 2048, (bf16*)(ws + WS_WIN) + (size_t)l * N_IN * 2048, in[7] + l * 2048, scr, r / 192, r % 192, lane); continue; } r -= I_IN;
        if (r < I_GLU) { p0_transpose_item(in[20] + (size_t)l * 1024 * 1024, 1024, 1024, (bf16*)(ws + WS_WGLU) + (size_t)l * 1024 * 1024, nullptr, scr, r / 32, r % 32, lane); continue; } r -= I_GLU;
        { const int kb = r / 64; const float* gn = (kb < 16) ? in[22] + l * 1024 : in[23] + l * 1024 - 1024;
          p0_transpose_item(in[24] + (size_t)l * 2048 * 2048, 2048, 2048, (bf16*)(ws + WS_WOUT) + (size_t)l * 2048 * 2048, gn, scr, kb, r % 64, lane); } }
    for (int it = gw; it < DEPTH * 16; it += NGW) { const int l = it >> 4, h = it & 15; bf16* wf = (bf16*)(ws + WS_WF) + (size_t)it * 2048;
        for (int k = lane; k < 2048; k += 64) { const float v = (h < 8) ? in[7][l * 2048 + k] * in[8][((size_t)l * 2048 + k) * D_PROJ + N_IN + h] : 0.f; wf[k] = (bf16)f2bf(v); } }
    float* rowsq0 = (float*)(ws + WS_CTL) + CW_ROWSQ;
    for (int m = gw; m < MROWS; m += NGW) { const float* xr = (m < MP) ? in[0] + (size_t)m * 2048 : in[1] + (size_t)(m - MP) * 2048;
        p0_row_item(xr, (bf16*)(ws + WS_XB) + (size_t)m * 2048, rowsq0 + m, lane); }
}

__device__ __forceinline__ float log_sigmoid(float x) { return (x >= 0.f) ? -log1pf(expf(-x)) : x - log1pf(expf(x)); }

__device__ __forceinline__ void fpre_stage_wf(const bf16* WF, LAS unsigned char* lds, int tid) {
    for (int c = tid; c < 8 * 256; c += 512) { const int r = c >> 8, kc = c & 255; *(LAS v4u*)(lds + r * 4112 + kc * 16) = *(const GAS v4u*)(WF + (size_t)r * 2048 + kc * 8); }
    LDS_WAIT(); __syncthreads();
}
__device__ __forceinline__ void fpre_item(int item, const bf16* XB, const LAS unsigned char* wfl, const float* rowsq, const float* bfv, float* LOGF, float* out_p, float* out_s, int lane) {
    const int row0 = item * 16, fr = lane & 15, fq = lane >> 4;
    const bf16* a = XB + (size_t)(row0 + fr) * 2048 + 8 * fq; const LAS unsigned char* b = wfl + (fr & 7) * 4112 + fq * 16;
    f32x4 acc = {0.f, 0.f, 0.f, 0.f};
#pragma unroll 1
    for (int kh = 0; kh < 2; ++kh) { bf16x8 av[32];
#pragma unroll
        for (int kk = 0; kk < 32; ++kk) av[kk] = *(const bf16x8*)(a + (kh * 32 + kk) * 32);
#pragma unroll
        for (int kk = 0; kk < 32; ++kk) { const bf16x8 bv = *(const LAS bf16x8*)(b + (kh * 32 + kk) * 64); acc = MFMA16(av[kk], bv, acc); } }
    if (fr < 8) {
#pragma unroll
        for (int i = 0; i < 4; ++i) { const int row = row0 + 4 * fq + i; const float rs = rsqrtf(rowsq[row] * (1.0f / 2048.0f) + EPS);
            const float lf = log_sigmoid(acc[i] * rs + bfv[fr]); LOGF[row * 8 + fr] = lf;
            if (row < MP) out_p[row * 8 + fr] = lf; else out_s[(row - MP) * 8 + fr] = lf; } }
}

__device__ __forceinline__ void e16_item(int item, const bf16* U, const bf16* WT, float* E16, int lane) {
    const int nh = item & 1, t2 = item >> 1, jb = t2 % 36, g = t2 / 36, r32 = lane & 31, hi = lane >> 5;
    const bf16* bp = U + ((size_t)g * MROWS + (size_t)(jb * 32 + r32) * 16) * 16 + 8 * hi;
    const bf16* ap = WT + ((size_t)(g * 128 + nh * 64 + r32)) * 256 + 8 * hi;
    f32x16 acc0 = {}, acc1 = {};
#pragma unroll 4
    for (int s = 0; s < 16; ++s) { const bf16x8 b = *(const bf16x8*)(bp + 16 * s); const bf16x8 a0 = *(const bf16x8*)(ap + 16 * s), a1 = *(const bf16x8*)(ap + 32 * 256 + 16 * s);
        acc0 = MFMA32(a0, b, acc0); acc1 = MFMA32(a1, b, acc1); }
    float* ep = E16 + ((size_t)(jb * 32 + r32) * 64 + g) * 128 + nh * 64 + 4 * hi;
#pragma unroll
    for (int rq = 0; rq < 4; ++rq) { *(f32x4*)(ep + 8 * rq) = (f32x4){acc0[4 * rq], acc0[4 * rq + 1], acc0[4 * rq + 2], acc0[4 * rq + 3]};
        *(f32x4*)(ep + 32 + 8 * rq) = (f32x4){acc1[4 * rq], acc1[4 * rq + 1], acc1[4 * rq + 2], acc1[4 * rq + 3]}; }
}

__device__ __forceinline__ void carry_prompt_item(int item, const float* E16, const float* A16, bf16* HS, float* out_re, float* out_im, LAS float* scr, int wave, int lane) {
    const int b = item >> 6, g = item & 63, p = lane;
    const float ar = A16[(g * 64 + p) * 2], ai = A16[(g * 64 + p) * 2 + 1];
    const int j0 = b * 512 + wave * 64;
    const float* ep = E16 + ((size_t)j0 * 64 + g) * 128 + p;
    float hr = 0.f, hm = 0.f;
#pragma unroll 1
    for (int jb = 0; jb < 2; ++jb) { float er[32], ei[32];
#pragma unroll
        for (int j = 0; j < 32; ++j) { er[j] = ep[(size_t)(jb * 32 + j) * 8192]; ei[j] = ep[(size_t)(jb * 32 + j) * 8192 + 64]; }
#pragma unroll
        for (int j = 0; j < 32; ++j) { const float nr = ar * hr - ai * hm + er[j], ni = ar * hm + ai * hr + ei[j]; hr = nr; hm = ni; } }
    scr[(wave * 64 + p) * 2] = hr; scr[(wave * 64 + p) * 2 + 1] = hm;
    float sr = ar, si = ai;
#pragma unroll
    for (int q = 0; q < 6; ++q) { const float t = sr * sr - si * si; si = 2.f * sr * si; sr = t; }
    LDS_WAIT(); __syncthreads();
    float cr = 0.f, ci = 0.f;
    for (int v = 0; v < wave; ++v) { const float xr = scr[(v * 64 + p) * 2], xi = scr[(v * 64 + p) * 2 + 1]; const float nr = sr * cr - si * ci + xr, ni = sr * ci + si * cr + xi; cr = nr; ci = ni; }
    bf16* hp = HS + ((size_t)j0 * 64 + g) * 128 + p;
    hr = cr; hm = ci; asm volatile("" ::: "memory");
#pragma unroll 1
    for (int jb = 0; jb < 2; ++jb) { float er[32], ei[32];
#pragma unroll
        for (int j = 0; j < 32; ++j) { er[j] = ep[(size_t)(jb * 32 + j) * 8192]; ei[j] = ep[(size_t)(jb * 32 + j) * 8192 + 64]; }
#pragma unroll
        for (int j = 0; j < 32; ++j) { hp[(size_t)(jb * 32 + j) * 8192] = (bf16)f2bf(hr); hp[(size_t)(jb * 32 + j) * 8192 + 64] = (bf16)f2bf(hm);
            const float nr = ar * hr - ai * hm + er[j], ni = ar * hm + ai * hr + ei[j]; hr = nr; hm = ni; } }
    if (wave == 7) { out_re[(b * 64 + g) * 64 + p] = hr; out_im[(b * 64 + g) * 64 + p] = hm; }
    __syncthreads();
}
__device__ __forceinline__ void carry_sample_item(int item, const float* E16, const float* A16, const float* h0r, const float* h0i, bf16* HS, float* out_re, float* out_im, int lane) {
    const int b = item >> 6, g = item & 63, p = lane;
    const float ar = A16[(g * 64 + p) * 2], ai = A16[(g * 64 + p) * 2 + 1];
    const int j0 = MP / 16 + b * 4;
    const float* ep = E16 + ((size_t)j0 * 64 + g) * 128 + p; bf16* hp = HS + ((size_t)j0 * 64 + g) * 128 + p;
    float hr = h0r[(b * 64 + g) * 64 + p], hm = h0i[(b * 64 + g) * 64 + p];
#pragma unroll
    for (int j = 0; j < 4; ++j) { hp[(size_t)j * 8192] = (bf16)f2bf(hr); hp[(size_t)j * 8192 + 64] = (bf16)f2bf(hm);
        const float xr = ep[(size_t)j * 8192], xi = ep[(size_t)j * 8192 + 64]; const float nr = ar * hr - ai * hm + xr, ni = ar * hm + ai * hr + xi; hr = nr; hm = ni; }
    out_re[(b * 64 + g) * 64 + p] = hr; out_im[(b * 64 + g) * 64 + p] = hm;
}

__device__ __forceinline__ void store_kb(bf16* kp, float c) {
    const float val = -c * SQRT_HD; const unsigned h0 = f2bf(val); const float r1 = val - bf2f(h0); const unsigned h1 = f2bf(r1); const float r2 = r1 - bf2f(h1); const unsigned h2 = f2bf(r2);
    v4u a; a.x = h0 | (h1 << 16); a.y = h2; a.z = 0u; a.w = 0u; v4u z = {0u, 0u, 0u, 0u};
    *(GAS v4u*)kp = a; *(GAS v4u*)(kp + 8) = z;
}
__device__ __forceinline__ void cumsum_prompt_item(int item, const float* LOGF, bf16* KBP, int* JLO, float ub2t, LAS float* scr, int tid, int wave, int lane) {
    const int b = item >> 3, h = item & 7;
    const float* lp = LOGF + ((size_t)(b * P_SEQ + tid * 16)) * 8 + h;
    float v[16];
#pragma unroll
    for (int i = 0; i < 16; ++i) v[i] = lp[i * 8];
    float run = 0.f;
#pragma unroll
    for (int i = 0; i < 16; ++i) { run += v[i]; v[i] = run; }
    float x = run;
#pragma unroll
    for (int o = 1; o < 64; o <<= 1) { const float y = __shfl_up(x, o); if (lane >= o) x += y; }
    if (lane == 63) scr[wave] = x;
    LDS_WAIT(); __syncthreads();
    float base = x - run;
    for (int w = 0; w < wave; ++w) base += scr[w];
    bf16* kp = KBP + ((size_t)item * P_SEQ + tid * 16) * 16;
#pragma unroll
    for (int i = 0; i < 16; ++i) store_kb(kp + i * 16, base + v[i]);
    if ((tid & 3) == 3) scr[16 + (tid >> 2)] = base + v[15];
    if ((tid & 15) == 0) scr[144 + (tid >> 4)] = base + v[0];
    LDS_WAIT(); __syncthreads();
    if (tid < 32) { const float lim = scr[144 + tid] + ub2t; int j = 0; while (j < 4 * tid && scr[16 + j] > lim) ++j; JLO[item * 32 + tid] = j; }
    __syncthreads();
}
__device__ __forceinline__ void cumsum_sample_item(int item, const float* cache_logf  , const float* LOGF, bf16* KBS, int* TLO, float ub2t, int lane) {
    const int b = item >> 3, h = item & 7;
    float v[17]; float run = 0.f;
#pragma unroll
    for (int i = 0; i < 17; ++i) { const int s = lane * 17 + i; const float x = (s < PAST) ? cache_logf[((size_t)b * PAST + s) * 8 + h] : LOGF[((size_t)(MP + b * S_SEQ + s - PAST)) * 8 + h]; run += x; v[i] = run; }
    float x = run;
#pragma unroll
    for (int o = 1; o < 64; o <<= 1) { const float y = __shfl_up(x, o); if (lane >= o) x += y; }
    const float base = x - run;
    bf16* kp = KBS + ((size_t)item * (PAST + S_SEQ) + lane * 17) * 16;
#pragma unroll
    for (int i = 0; i < 17; ++i) store_kb(kp + i * 16, base + v[i]);
    const float lim = __shfl(base + v[4], 60) + ub2t; int tl = 0;
#pragma unroll
    for (int i = 0; i < 17; ++i) { const int s = lane * 17 + i; if ((s & 63) == 63 && s < PAST && base + v[i] > lim) tl = (s >> 6) + 1; }
#pragma unroll
    for (int o = 1; o < 64; o <<= 1) tl = max(tl, __shfl_xor(tl, o));
    if (lane == 0) TLO[item] = tl;
}

__device__ __forceinline__ void sc_item(int item, const bf16* U, const bf16* HS, const bf16* BC, bf16* ZS, int lane) {
    const int nq = item & 1, t2 = item >> 1, jb = t2 % 36, g = t2 / 36, r32 = lane & 31, hi = lane >> 5, j = jb * 32 + r32;
    const bf16* bu = U + ((size_t)g * MROWS + (size_t)j * 16) * 16 + 8 * hi;
    const bf16* bh = HS + ((size_t)j * 64 + g) * 128 + 8 * hi;
    const bf16* ap = BC + ((size_t)(g * 256 + nq * 128 + r32)) * 384 + 8 * hi;
    f32x16 acc0 = {}, acc1 = {}, acc2 = {}, acc3 = {};
#pragma unroll 4
    for (int s = 0; s < 16; ++s) { const bf16x8 b = *(const bf16x8*)(bu + 16 * s);
        const bf16x8 a0 = *(const bf16x8*)(ap + 16 * s), a1 = *(const bf16x8*)(ap + 32 * 384 + 16 * s), a2 = *(const bf16x8*)(ap + 64 * 384 + 16 * s), a3 = *(const bf16x8*)(ap + 96 * 384 + 16 * s);
        acc0 = MFMA32(a0, b, acc0); acc1 = MFMA32(a1, b, acc1); acc2 = MFMA32(a2, b, acc2); acc3 = MFMA32(a3, b, acc3); }
#pragma unroll 4
    for (int s = 0; s < 8; ++s) { const bf16x8 b = *(const bf16x8*)(bh + 16 * s); const bf16* aq = ap + 256 + 16 * s;
        const bf16x8 a0 = *(const bf16x8*)(aq), a1 = *(const bf16x8*)(aq + 32 * 384), a2 = *(const bf16x8*)(aq + 64 * 384), a3 = *(const bf16x8*)(aq + 96 * 384);
        acc0 = MFMA32(a0, b, acc0); acc1 = MFMA32(a1, b, acc1); acc2 = MFMA32(a2, b, acc2); acc3 = MFMA32(a3, b, acc3); }
#define SC_STORE(ACC, nb) do { _Pragma("unroll") for (int rq = 0; rq < 4; ++rq) { const int n0 = nq * 128 + (nb) * 32 + 8 * rq + 4 * hi; const int t = n0 >> 4, c0 = n0 & 15; \
        const pg8::f32x2 ga = pg8::gelu_pk((pg8::f32x2){ACC[4 * rq], ACC[4 * rq + 1]}), gb = pg8::gelu_pk((pg8::f32x2){ACC[4 * rq + 2], ACC[4 * rq + 3]}); \
        v2u w; w.x = pg8::cvt_pk_bf16(ga.x, ga.y); w.y = pg8::cvt_pk_bf16(gb.x, gb.y); *(GAS v2u*)(ZS + (size_t)(16 * j + t) * 1024 + g * 16 + c0) = w; } } while (0)
    SC_STORE(acc0, 0); SC_STORE(acc1, 1); SC_STORE(acc2, 2); SC_STORE(acc3, 3);
#undef SC_STORE
}

__device__ __forceinline__ float sumsq8(v4u a) { float s = 0.f;
    s += bf2f(a.x & 0xffffu) * bf2f(a.x & 0xffffu) + __uint_as_float(a.x & 0xffff0000u) * __uint_as_float(a.x & 0xffff0000u);
    s += bf2f(a.y & 0xffffu) * bf2f(a.y & 0xffffu) + __uint_as_float(a.y & 0xffff0000u) * __uint_as_float(a.y & 0xffff0000u);
    s += bf2f(a.z & 0xffffu) * bf2f(a.z & 0xffffu) + __uint_as_float(a.z & 0xffff0000u) * __uint_as_float(a.z & 0xffff0000u);
    s += bf2f(a.w & 0xffffu) * bf2f(a.w & 0xffffu) + __uint_as_float(a.w & 0xffff0000u) * __uint_as_float(a.w & 0xffff0000u);
    return s; }
__device__ __forceinline__ unsigned scale2(unsigned w, float s) { return pk2(bf2f(w & 0xffffu) * s, __uint_as_float(w & 0xffff0000u) * s); }
__device__ __forceinline__ v4u scale8(v4u a, float s) { v4u o; o.x = scale2(a.x, s); o.y = scale2(a.y, s); o.z = scale2(a.z, s); o.w = scale2(a.w, s); return o; }
__device__ __forceinline__ void norm_row_item(bf16* yrow, int lane) {
    GAS v4u* p = (GAS v4u*)yrow + lane;
    const v4u a0 = p[0], a1 = p[64], b0 = p[128], b1 = p[192];
    const float ss = wave_sum(sumsq8(a0) + sumsq8(a1)), sa = wave_sum(sumsq8(b0) + sumsq8(b1));
    const float rs = rsqrtf(ss * (1.0f / 1024.0f) + EPS), ra = rsqrtf(sa * (1.0f / 1024.0f) + EPS);
    p[0] = scale8(a0, rs); p[64] = scale8(a1, rs); p[128] = scale8(b0, ra); p[192] = scale8(b1, ra);
}

__device__ __forceinline__ void sc_block_item(int item, const bf16* U, const bf16* HS, const bf16* BC, bf16* ZS, LAS unsigned char* lds, int tid, int wave, int lane) {
    const int g = item >> 2, nq = item & 3, r32 = lane & 31, hi = lane >> 5;
    const bf16* src = BC + ((size_t)(g * 256 + nq * 64)) * 384;
    for (int c = tid; c < 64 * 48; c += 512) { const int r = c / 48, kc = c - r * 48; *(LAS v4u*)(lds + r * 784 + kc * 16) = *(const GAS v4u*)(src + (size_t)r * 384 + kc * 8); }
    LDS_WAIT(); __syncthreads();
    const LAS unsigned char* ap = lds + r32 * 784 + hi * 16;
#pragma unroll 1
    for (int jb = wave; jb < 36; jb += 8) {
        const int j = jb * 32 + r32;
        const bf16* bu = U + ((size_t)g * MROWS + (size_t)j * 16) * 16 + 8 * hi;
        const bf16* bh = HS + ((size_t)j * 64 + g) * 128 + 8 * hi;
        bf16x8 bf[24];
#pragma unroll
        for (int s = 0; s < 16; ++s) bf[s] = *(const bf16x8*)(bu + 16 * s);
#pragma unroll
        for (int s = 0; s < 8; ++s) bf[16 + s] = *(const bf16x8*)(bh + 16 * s);
        f32x16 acc0 = {}, acc1 = {};
#pragma unroll
        for (int s = 0; s < 24; ++s) { const bf16x8 a0 = *(const LAS bf16x8*)(ap + s * 32), a1 = *(const LAS bf16x8*)(ap + 32 * 784 + s * 32);
            acc0 = MFMA32(a0, bf[s], acc0); acc1 = MFMA32(a1, bf[s], acc1); }
#define SC_STORE(ACC, nb) do { _Pragma("unroll") for (int rq = 0; rq < 4; ++rq) { const int n0 = nq * 64 + (nb) * 32 + 8 * rq + 4 * hi; const int t = n0 >> 4, c0 = n0 & 15; \
        const pg8::f32x2 ga = pg8::gelu_pk((pg8::f32x2){ACC[4 * rq], ACC[4 * rq + 1]}), gb = pg8::gelu_pk((pg8::f32x2){ACC[4 * rq + 2], ACC[4 * rq + 3]}); \
        v2u w; w.x = pg8::cvt_pk_bf16(ga.x, ga.y); w.y = pg8::cvt_pk_bf16(gb.x, gb.y); *(GAS v2u*)(ZS + (size_t)(16 * j + t) * 1024 + g * 16 + c0) = w; } } while (0)
        SC_STORE(acc0, 0); SC_STORE(acc1, 1);
#undef SC_STORE
    }
    __syncthreads();
}
__device__ __forceinline__ void e16_block_item(int item, const bf16* U, const bf16* WT, float* E16, LAS unsigned char* lds, int tid, int wave, int lane) {
    const int g = item >> 2, nq = item & 3, r32 = lane & 31, hi = lane >> 5;
    const bf16* src = WT + ((size_t)(g * 128 + nq * 32)) * 256;
    for (int c = tid; c < 32 * 32; c += 512) { const int r = c >> 5, kc = c & 31; *(LAS v4u*)(lds + r * 528 + kc * 16) = *(const GAS v4u*)(src + (size_t)r * 256 + kc * 8); }
    LDS_WAIT(); __syncthreads();
    const LAS unsigned char* ap = lds + r32 * 528 + hi * 16;
#pragma unroll 1
    for (int jb = wave; jb < 36; jb += 8) {
        const int j = jb * 32 + r32;
        const bf16* bu = U + ((size_t)g * MROWS + (size_t)j * 16) * 16 + 8 * hi;
        bf16x8 bf[16];
#pragma unroll
        for (int s = 0; s < 16; ++s) bf[s] = *(const bf16x8*)(bu + 16 * s);
        f32x16 acc = {};
#pragma unroll
        for (int s = 0; s < 16; ++s) { const bf16x8 a0 = *(const LAS bf16x8*)(ap + s * 32); acc = MFMA32(a0, bf[s], acc); }
        float* ep = E16 + ((size_t)j * 64 + g) * 128 + nq * 32 + 4 * hi;
#pragma unroll
        for (int rq = 0; rq < 4; ++rq) *(f32x4*)(ep + 8 * rq) = (f32x4){acc[4 * rq], acc[4 * rq + 1], acc[4 * rq + 2], acc[4 * rq + 3]};
    }
    __syncthreads();
}

namespace fox {
constexpr int NW = 8, QBLK = 32, KVBLK = 64, QB = NW * QBLK, D = 128, PITCH = 1024;
constexpr int SHM_V = KVBLK * D * 2, SHM_K = KVBLK * D * 2;
constexpr int LDS_ATT = 2 * SHM_V + 2 * SHM_K + NW * 64 * 4;
constexpr float SCALE = 0.08838834764831845f, THR = 8.f;
typedef short s16x4 __attribute__((ext_vector_type(4)));
#define KSWZ(row, colB) ((row) * 256 + ((colB) ^ (((row) & 7) << 4)))
#define SBAR() __builtin_amdgcn_sched_barrier(0)
__device__ __forceinline__ int v_st(int k, int c) { const int kk = (k & ~0xC) | ((k & 4) << 1) | ((k & 8) >> 1); return ((kk >> 3) * 4 + (c >> 5)) * 512 + ((kk & 7) * 32 + (c & 31)) * 2; }
__device__ __forceinline__ int v_rd_base(int lane) { return ((lane & 3) << 3) | (((lane >> 2) & 3) << 6) | (((lane >> 4) & 1) << 5) | (((lane >> 5) & 1) << 8); }
constexpr int v_rd_off(int d0, int ks, int half) { return d0 * 512 + ks * 4096 + half * 2048; }
__device__ __forceinline__ unsigned cvtpk(float lo, float hi) { unsigned r; asm volatile("v_cvt_pk_bf16_f32 %0, %1, %2" : "=v"(r) : "v"(lo), "v"(hi)); return r; }
__device__ __forceinline__ bf16x8 pack8(f32x4 a, f32x4 b) { v4u w = {cvtpk(a[0], a[1]), cvtpk(a[2], a[3]), cvtpk(b[0], b[1]), cvtpk(b[2], b[3])}; return *reinterpret_cast<bf16x8*>(&w); }
__device__ __forceinline__ bf16x8 ld8(const bf16* p) { return *reinterpret_cast<const bf16x8*>(p); }
__device__ __forceinline__ void mask_tile(f32x16& p0, f32x16& p1, int dq) {
    const float NEG = -__builtin_inff();
#pragma unroll
    for (int r = 0; r < 16; ++r) { const int c = (r & 3) + 8 * (r >> 2); if (dq - c < 0) p0[r] = NEG; if (dq - c - 32 < 0) p1[r] = NEG; }
}
__device__ __forceinline__ void partialSM(f32x16& p0, f32x16& p1, float& m_reg, float& mn, float& alpha) {
    float pmax = p0[0];
#pragma unroll
    for (int r = 1; r < 16; ++r) pmax = fmaxf(pmax, p0[r]);
#pragma unroll
    for (int r = 0; r < 16; ++r) pmax = fmaxf(pmax, p1[r]);
    { auto rr = __builtin_amdgcn_permlane32_swap(__float_as_uint(pmax), __float_as_uint(pmax), false, false); pmax = fmaxf(__uint_as_float(rr[0]), __uint_as_float(rr[1])); }
    constexpr float C2 = 1.4426950408889634f * SCALE;
    if (__builtin_expect(__all((pmax - m_reg) * SCALE <= THR), 1)) { mn = m_reg; alpha = 1.f; }
    else { mn = fmaxf(m_reg, pmax); alpha = __builtin_amdgcn_exp2f((m_reg - mn) * C2); m_reg = mn; }
    const float mnL = -mn * C2;
#pragma unroll
    for (int r = 0; r < 16; ++r) p0[r] = fmaf(p0[r], C2, mnL);
#pragma unroll
    for (int r = 0; r < 16; ++r) p1[r] = fmaf(p1[r], C2, mnL);
#pragma unroll
    for (int r = 0; r < 16; ++r) p0[r] = __builtin_amdgcn_exp2f(p0[r]);
}
__device__ __forceinline__ void finishSM(f32x16& p0, f32x16& p1, float alpha, float& l_reg, bf16x8& pa0, bf16x8& pa1, bf16x8& pa2, bf16x8& pa3) {
#pragma unroll
    for (int r = 0; r < 16; ++r) p1[r] = __builtin_amdgcn_exp2f(p1[r]);
    float ps = 0;
#pragma unroll
    for (int r = 0; r < 16; ++r) ps += p0[r];
#pragma unroll
    for (int r = 0; r < 16; ++r) ps += p1[r];
    { auto rr = __builtin_amdgcn_permlane32_swap(__float_as_uint(ps), __float_as_uint(ps), false, false); ps = __uint_as_float(rr[0]) + __uint_as_float(rr[1]); }
    l_reg = l_reg * alpha + ps;
#define PK4(P, B_, OUT) do { unsigned a0 = cvtpk(P[B_+0], P[B_+1]), a1 = cvtpk(P[B_+2], P[B_+3]); unsigned b0 = cvtpk(P[B_+4], P[B_+5]), b1 = cvtpk(P[B_+6], P[B_+7]); \
        auto r0 = __builtin_amdgcn_permlane32_swap(a0, b0, false, false); auto r1 = __builtin_amdgcn_permlane32_swap(a1, b1, false, false); \
        v4u w = {r0[0], r1[0], r0[1], r1[1]}; OUT = *reinterpret_cast<bf16x8*>(&w); } while (0)
    PK4(p0, 0, pa0); PK4(p0, 8, pa1); PK4(p1, 0, pa2); PK4(p1, 8, pa3);
#undef PK4
}
__device__ __forceinline__ void qkt(f32x16& p0, f32x16& p1, const char* Kt, int r32, int hi, const bf16x8* qr, const bf16* kbp, bf16x8 qone) {
    const bf16x8 kb0 = ld8(kbp), kb1 = ld8(kbp + 32 * 16);
    p0 = f32x16{}; p1 = f32x16{};
    const char* kb[4];
#pragma unroll
    for (int dd = 0; dd < 4; ++dd) kb[dd] = Kt + KSWZ(r32, (dd * 16 + hi * 8) * 2);
#pragma unroll
    for (int d0 = 0; d0 < 8; ++d0) { const char* a = kb[d0 & 3] + (d0 >> 2) * 128;
        bf16x8 b0 = *reinterpret_cast<const bf16x8*>(a); bf16x8 b1 = *reinterpret_cast<const bf16x8*>(a + 32 * 256);
        p0 = MFMA32(b0, qr[d0], p0); p1 = MFMA32(b1, qr[d0], p1); }
    p0 = MFMA32(kb0, qone, p0); p1 = MFMA32(kb1, qone, p1);
}
template <int VOFF>
__device__ __forceinline__ void pv_tile(f32x16* o, int vb0, bf16x8 pa0, bf16x8 pa1, bf16x8 pa2, bf16x8 pa3) {
#define TRRD(dst, off) asm volatile("ds_read_b64_tr_b16 %0, %1 offset:%2" : "=&v"(dst) : "v"(vb0), "i"(off) : "memory")
#define PV_D0(d0) do { s16x4 l0, l1, l2, l3, h0, h1, h2, h3; constexpr int b_ = VOFF + v_rd_off(d0, 0, 0); \
        TRRD(l0, b_); TRRD(h0, b_ + 2048); TRRD(l1, b_ + 4096); TRRD(h1, b_ + 6144); TRRD(l2, b_ + 8192); TRRD(h2, b_ + 10240); TRRD(l3, b_ + 12288); TRRD(h3, b_ + 14336); \
        asm volatile("s_waitcnt lgkmcnt(0)" ::: "memory"); SBAR(); \
        o[d0] = MFMA32(pa0, ((bf16x8){l0[0], l0[1], l0[2], l0[3], h0[0], h0[1], h0[2], h0[3]}), o[d0]); \
        o[d0] = MFMA32(pa1, ((bf16x8){l1[0], l1[1], l1[2], l1[3], h1[0], h1[1], h1[2], h1[3]}), o[d0]); \
        o[d0] = MFMA32(pa2, ((bf16x8){l2[0], l2[1], l2[2], l2[3], h2[0], h2[1], h2[2], h2[3]}), o[d0]); \
        o[d0] = MFMA32(pa3, ((bf16x8){l3[0], l3[1], l3[2], l3[3], h3[0], h3[1], h3[2], h3[3]}), o[d0]); } while (0)
    PV_D0(0); PV_D0(1); PV_D0(2); PV_D0(3);
#undef PV_D0
#undef TRRD
}
__device__ __forceinline__ void store_o(const f32x16* o, const float* li_l, const bf16* SZw, bf16* Ow, int r32, int hi) {
    float rli[16];
#pragma unroll
    for (int r = 0; r < 16; ++r) rli[r] = __builtin_amdgcn_rcpf(li_l[crow(r, hi)]);
#pragma unroll
    for (int r = 0; r < 16; ++r) { const int orow = crow(r, hi);
#pragma unroll
        for (int d0 = 0; d0 < 4; ++d0) { const float z = bf2f(SZw[(size_t)orow * PITCH + d0 * 32 + r32]); const float v = o[d0][r] * rli[r] * z;
            const float vn = __shfl_xor(v, 1);
            if ((r32 & 1) == 0) *(unsigned*)(Ow + (size_t)orow * 2048 + d0 * 32 + r32) = cvtpk(v, vn); } }
}

struct BlockRef { const bf16* Q; const bf16* K; const bf16* V; const bf16* KB; const bf16* SZ; bf16* O; int P0; int jlo; };
struct Seam { bf16x8 qr[8]; bf16x8 st_v0, st_v1, st_k0, st_k1; };
#define ROW(p, k0, rr) ((p) + (unsigned)(((k0) + (rr)) * PITCH + sc))
#define VMW() asm volatile("s_waitcnt vmcnt(0)" ::: "memory")
#define VMWN(n) asm volatile("s_waitcnt vmcnt(%0)" :: "i"(n) : "memory")
#define SLOAD_H(Kp, Vp, k0) do { S.st_v0 = ld8(ROW(Vp, k0, sr)); S.st_v1 = ld8(ROW(Vp, k0, 32 + sr)); S.st_k0 = ld8(ROW(Kp, k0, sr)); S.st_k1 = ld8(ROW(Kp, k0, 32 + sr)); } while (0)
#define SWRITE_HK(bf) do { *(bf16x8*)(K_lds + (bf) * SHM_K + kws) = S.st_k0; *(bf16x8*)(K_lds + (bf) * SHM_K + kws + 32 * 256) = S.st_k1; } while (0)
#define SWRITE_HV(bf) do { *(bf16x8*)(V_lds + (bf) * SHM_V + vst0) = S.st_v0; *(bf16x8*)(V_lds + (bf) * SHM_V + vst1) = S.st_v1; } while (0)
#define SWRITE_H(bf) do { SWRITE_HV(bf); SWRITE_HK(bf); } while (0)
__device__ __forceinline__ void fox_prime(const BlockRef& cur, char* lds, Seam& S) {
    int tid_ = threadIdx.x; asm volatile("" : "+v"(tid_));
    const int tid = tid_, wid = __builtin_amdgcn_readfirstlane(tid >> 6), lane = tid & 63, r32 = lane & 31, hi = lane >> 5;
    const int sr = tid >> 4, sc = (tid & 15) * 8, kws = KSWZ(sr, sc * 2); char* K_lds = lds + 2 * SHM_V;
#pragma unroll
    for (int d0 = 0; d0 < 8; ++d0) S.qr[d0] = ld8(cur.Q + (size_t)(wid * QBLK + r32) * PITCH + d0 * 16 + hi * 8);
    SLOAD_H(cur.K, cur.V, cur.jlo * KVBLK); VMW(); SWRITE_HK(0);
    __syncthreads();
}
__device__ __forceinline__ void fox_block(const BlockRef& cur, const BlockRef& nxt, char* lds, Seam& S, bf16x8 qone) {
    int tid_ = threadIdx.x; asm volatile("" : "+v"(tid_));
    const int tid = tid_, wid = __builtin_amdgcn_readfirstlane(tid >> 6), lane = tid & 63, r32 = lane & 31, hi = lane >> 5;
    const int j_lo = cur.jlo, NT = (cur.P0 + QB - 1) / KVBLK + 1 - j_lo;
    const int kbn = nxt.jlo * KVBLK;
    const int qlo = cur.P0 + wid * QBLK, qm = qlo + r32 - 4 * hi;
    char* V_lds = lds; char* K_lds = lds + 2 * SHM_V;
    float* ws = (float*)(lds + 2 * SHM_V + 2 * SHM_K) + wid * 64; float* li_l = ws, * al_l = ws + 32;
    float m_reg = -1e30f, l_reg = 0; f32x16 o[4] = {};
    const int sr = tid >> 4, sc = (tid & 15) * 8, vst0 = v_st(sr, sc), vst1 = v_st(32 + sr, sc), kws = KSWZ(sr, sc * 2);
    const int vb0 = (int)(uintptr_t)V_lds + v_rd_base(lane);
    const bf16* Kh = cur.K; const bf16* Vh = cur.V; const bf16* KBh = cur.KB; const unsigned kbl = (unsigned)(r32 * 16 + hi * 8);
#define RESC(a) do { if (__any((a) < 1.f)) { if (hi == 0) al_l[r32] = (a); asm volatile("s_waitcnt lgkmcnt(0)" ::: "memory"); \
                     _Pragma("unroll") for (int d_ = 0; d_ < 4; ++d_) _Pragma("unroll") for (int r = 0; r < 16; ++r) o[d_][r] *= al_l[crow(r, hi)]; } } while (0)
#define KBASE(t) ((j_lo + (t)) * KVBLK)
#define MASKT(P0_, P1_, t) do { const int kb_ = KBASE(t); if (kb_ + KVBLK - 1 > qlo) mask_tile(P0_, P1_, qm - kb_); } while (0)
    constexpr int NQL = 8;
#define SEAM_K0() do { VMWN(NQL); SWRITE_HK(0); SBAR(); } while (0)
    f32x16 pA0, pA1, pB0, pB1; float mnA, mnB, alA, alB; bf16x8 pa0, pa1, pa2, pa3;
    SWRITE_HV(0); SBAR();
    if (NT > 1) SLOAD_H(Kh, Vh, KBASE(1));
    SBAR(); qkt(pA0, pA1, K_lds, r32, hi, S.qr, KBh + (kbl + (unsigned)KBASE(0) * 16u), qone);
    MASKT(pA0, pA1, 0); partialSM(pA0, pA1, m_reg, mnA, alA);
    if (NT > 1) { VMW(); SWRITE_H(1); }
    __syncthreads();
#define HALF_STEP(PX0, PX1, mnX, alX, PY0, PY1, alY, t, KBI, VBI, SBI) do { \
        SBAR(); qkt(PX0, PX1, K_lds + (KBI) * SHM_K, r32, hi, S.qr, KBh + (kbl + (unsigned)KBASE(t) * 16u), qone); \
        finishSM(PY0, PY1, alY, l_reg, pa0, pa1, pa2, pa3); SBAR(); \
        if ((t) + 1 < NT) { SLOAD_H(Kh, Vh, KBASE((t) + 1)); SBAR(); } \
        pv_tile<(VBI) * SHM_V>(o, vb0, pa0, pa1, pa2, pa3); MASKT(PX0, PX1, (t)); partialSM(PX0, PX1, m_reg, mnX, alX); \
        __syncthreads(); \
        if ((t) + 1 < NT) { VMW(); SWRITE_H(SBI); } \
        RESC(alX); __syncthreads(); } while (0)
    for (int t = 1; t + 1 < NT; t += 2) {
        HALF_STEP(pB0, pB1, mnB, alB, pA0, pA1, alA, t, 1, 0, 0);
        HALF_STEP(pA0, pA1, mnA, alA, pB0, pB1, alB, t + 1, 0, 1, 1);
    }
    const bool even = (NT & 1) == 0;
    if (even) { SBAR(); qkt(pB0, pB1, K_lds + SHM_K, r32, hi, S.qr, KBh + (kbl + (unsigned)KBASE(NT - 1) * 16u), qone); SBAR(); }
    SLOAD_H(nxt.K, nxt.V, kbn); SBAR();
#pragma unroll
    for (int d0 = 0; d0 < 8; ++d0) S.qr[d0] = ld8(nxt.Q + (size_t)(wid * QBLK + r32) * PITCH + d0 * 16 + hi * 8);
    SBAR();
    finishSM(pA0, pA1, alA, l_reg, pa0, pa1, pa2, pa3); SBAR();
    pv_tile<0>(o, vb0, pa0, pa1, pa2, pa3);
    if (even) { MASKT(pB0, pB1, NT - 1); partialSM(pB0, pB1, m_reg, mnB, alB); __syncthreads(); RESC(alB);
        finishSM(pB0, pB1, alB, l_reg, pa0, pa1, pa2, pa3); SBAR(); pv_tile<SHM_V>(o, vb0, pa0, pa1, pa2, pa3); }
    SBAR(); SEAM_K0();
    if (hi == 0) li_l[r32] = l_reg; asm volatile("s_waitcnt lgkmcnt(0)" ::: "memory");
    store_o(o, li_l, cur.SZ + (size_t)(wid * QBLK) * PITCH, cur.O + (size_t)(wid * QBLK) * 2048, r32, hi);
    __syncthreads();
#undef RESC
#undef KBASE
#undef MASKT
#undef SEAM_K0
#undef HALF_STEP
}
__device__ __forceinline__ BlockRef prompt_ref(int bh, int qb, const bf16* Qb, const bf16* Kb, const bf16* Vb, const bf16* KBP, const bf16* SZA, bf16* YN, const int* JLO) {
    const int b = bh >> 3, h = bh & 7; const size_t row0 = (size_t)b * P_SEQ + (size_t)qb * QB; BlockRef r;
    r.Q = Qb + row0 * PITCH + h * D; r.K = Kb + (size_t)b * P_SEQ * PITCH + h * D; r.V = Vb + (size_t)b * P_SEQ * PITCH + h * D; r.KB = KBP + (size_t)bh * P_SEQ * 16;
    r.SZ = SZA + row0 * PITCH + h * D; r.O = YN + row0 * 2048 + 1024 + h * D; r.P0 = qb * QB; r.jlo = JLO[bh * 32 + qb]; return r;
}
__device__ __forceinline__ void prompt_attn(int first, int G, const bf16* Qb, const bf16* Kb, const bf16* Vb, const bf16* KBP, const bf16* SZA, bf16* YN, const int* JLO, char* lds, bf16x8 qone) {
    int L = first; if (L >= 256) return;
    Seam S; int pass = 0; BlockRef cur = prompt_ref(L >> 4, L & 15, Qb, Kb, Vb, KBP, SZA, YN, JLO);
    fox_prime(cur, lds, S);
    for (;;) {
        const bool more_pass = pass == 0, more_item = L + G < 256, last = !more_pass && !more_item;
        int Ln = L, passn = pass + 1; if (!more_pass) { passn = 0; Ln = more_item ? L + G : L; }
        const int yn = Ln & 15; const BlockRef nxt = last ? cur : prompt_ref(Ln >> 4, passn ? 31 - yn : yn, Qb, Kb, Vb, KBP, SZA, YN, JLO);
        fox_block(cur, nxt, lds, S, qone);
        if (last) break;
        cur = nxt; pass = passn; L = Ln;
    }
}

__device__ __forceinline__ void fox_sample_unit(int b, int h, int tlo, const float* cK, const float* cV, const bf16* Kb, const bf16* Vb, const bf16* Qb, const bf16* KBS, const bf16* SZA, bf16* YN, char* lds, bf16x8 qone) {
    int tid_ = threadIdx.x; asm volatile("" : "+v"(tid_));
    const int tid = tid_, wid = __builtin_amdgcn_readfirstlane(tid >> 6), lane = tid & 63, r32 = lane & 31, hi = lane >> 5;
    const int sr = tid >> 4, sc = (tid & 15) * 8, vst0 = v_st(sr, sc), vst1 = v_st(32 + sr, sc), kws = KSWZ(sr, sc * 2);
    char* V_lds = lds; char* K_lds = lds + 2 * SHM_V;
    float* ws = (float*)(lds + 2 * SHM_V + 2 * SHM_K) + wid * 64; float* li_l = ws, * al_l = ws + 32;
    const int vb0 = (int)(uintptr_t)V_lds + v_rd_base(lane);
    const size_t rowq = (size_t)MP + (size_t)b * S_SEQ;
    const float* ck = cK + ((size_t)b * PAST) * 1024 + h * D + sc; const float* cv = cV + ((size_t)b * PAST) * 1024 + h * D + sc;
    const bf16* nk = Kb + rowq * PITCH + h * D + sc; const bf16* nv = Vb + rowq * PITCH + h * D + sc;
    const bf16* kbp = KBS + ((size_t)(b * 8 + h) * (PAST + S_SEQ) + r32) * 16 + hi * 8;
    const int wq = wid & 1;
    bf16x8 qr[8];
#pragma unroll
    for (int d0 = 0; d0 < 8; ++d0) qr[d0] = ld8(Qb + (rowq + wq * 32 + r32) * PITCH + h * D + d0 * 16 + hi * 8);
    float m_reg = -1e30f, l_reg = 0; f32x16 o[4] = {};
    f32x4 kf0, kf1, kf2, kf3, vf0, vf1, vf2, vf3;
#define LOADF(t) do { const float* kp_ = ck + (size_t)((t) * KVBLK + sr) * 1024; const float* vp_ = cv + (size_t)((t) * KVBLK + sr) * 1024; \
        kf0 = *(const f32x4*)kp_; kf1 = *(const f32x4*)(kp_ + 4); kf2 = *(const f32x4*)(kp_ + 32 * 1024); kf3 = *(const f32x4*)(kp_ + 32 * 1024 + 4); \
        vf0 = *(const f32x4*)vp_; vf1 = *(const f32x4*)(vp_ + 4); vf2 = *(const f32x4*)(vp_ + 32 * 1024); vf3 = *(const f32x4*)(vp_ + 32 * 1024 + 4); } while (0)
#define WRITEF(bf) do { *(bf16x8*)(K_lds + (bf) * SHM_K + kws) = pack8(kf0, kf1); *(bf16x8*)(K_lds + (bf) * SHM_K + kws + 32 * 256) = pack8(kf2, kf3); \
        *(bf16x8*)(V_lds + (bf) * SHM_V + vst0) = pack8(vf0, vf1); *(bf16x8*)(V_lds + (bf) * SHM_V + vst1) = pack8(vf2, vf3); } while (0)
#define LOADH() do { kf0 = *(const f32x4*)(nk + (size_t)sr * PITCH); kf1 = *(const f32x4*)(nk + (size_t)(32 + sr) * PITCH); vf0 = *(const f32x4*)(nv + (size_t)sr * PITCH); vf1 = *(const f32x4*)(nv + (size_t)(32 + sr) * PITCH); } while (0)
#define WRITEH(bf) do { *(f32x4*)(K_lds + (bf) * SHM_K + kws) = kf0; *(f32x4*)(K_lds + (bf) * SHM_K + kws + 32 * 256) = kf1; \
        *(f32x4*)(V_lds + (bf) * SHM_V + vst0) = vf0; *(f32x4*)(V_lds + (bf) * SHM_V + vst1) = vf1; } while (0)
#define RESC(a) do { if (__any((a) < 1.f)) { if (hi == 0) al_l[r32] = (a); asm volatile("s_waitcnt lgkmcnt(0)" ::: "memory"); \
                     _Pragma("unroll") for (int d_ = 0; d_ < 4; ++d_) _Pragma("unroll") for (int r = 0; r < 16; ++r) o[d_][r] *= al_l[crow(r, hi)]; } } while (0)
    constexpr int NTS = PAST / KVBLK + 1;
    const int t0 = (tlo < 14 ? tlo : 14) & ~1;
    LOADF(t0);
    VMW(); WRITEF(0); __syncthreads();
#pragma unroll 1
    for (int t = t0; t < NTS; t += 2) {
#define SSTEP(tt, BUF) do { \
        if ((tt) + 1 < NTS - 1) { LOADF((tt) + 1); } else if ((tt) + 1 == NTS - 1) { LOADH(); } \
        if (wid < 2) { f32x16 p0, p1; float mn, al; bf16x8 pa0, pa1, pa2, pa3; \
            qkt(p0, p1, K_lds + (BUF) * SHM_K, r32, hi, qr, kbp + (size_t)((tt) * KVBLK) * 16, qone); \
            if ((tt) == NTS - 1) mask_tile(p0, p1, wid * QBLK + r32 - 4 * hi); \
            partialSM(p0, p1, m_reg, mn, al); RESC(al); finishSM(p0, p1, al, l_reg, pa0, pa1, pa2, pa3); SBAR(); \
            pv_tile<(BUF) * SHM_V>(o, vb0, pa0, pa1, pa2, pa3); } \
        if ((tt) + 1 < NTS) { VMW(); if ((tt) + 1 < NTS - 1) { WRITEF((BUF) ^ 1); } else { WRITEH((BUF) ^ 1); } } \
        __syncthreads(); } while (0)
        SSTEP(t, 0);
        if (t + 1 < NTS) SSTEP(t + 1, 1);
#undef SSTEP
    }
    if (wid < 2) { if (hi == 0) li_l[r32] = l_reg; asm volatile("s_waitcnt lgkmcnt(0)" ::: "memory");
        store_o(o, li_l, SZA + (rowq + wid * QBLK) * PITCH + h * D, YN + (rowq + wid * QBLK) * 2048 + 1024 + h * D, r32, hi); }
    __syncthreads();
#undef LOADF
#undef WRITEF
#undef LOADH
#undef WRITEH
#undef RESC
}
#undef ROW
#undef VMW
#undef VMWN
#undef SLOAD_H
#undef SWRITE_HK
#undef SWRITE_HV
#undef SWRITE_H
#undef KSWZ
#undef SBAR
}
#define STAGE_B_PHASES \
          \
        if (IN(ph + 3)) { PHASE_PTRS; const bf16* BCl = (const bf16*)(ws + WS_BC) + (size_t)l * 64 * 256 * 384; \
            for (int rep_ = 0; rep_ < 1 + DUP_S5C; ++rep_) for (int it = vcu; it < 256; it += G) sc_block_item(it, Ub, HS, BCl, ZS, lds + RING_OFF, tid, wave, lane); } \
        SEAM(ph + 3); \
          \
        if (IN(ph + 4)) { PHASE_PTRS; \
            { pg8::Gemm g{ZS, (const bf16*)(ws + WS_WGLU) + (size_t)l * 1024 * 1024, MROWS, 1024, 1024}; pg8::GluOrder S{vcu, G}; \
              pg8::EpiGlu E{ws, inp[21] + l * 1024}; \
              for (int rep_ = 0; rep_ < 1 + DUP_GLU; ++rep_) pg8::gemm_phase<pg8::EpiGlu, pg8::GluOrder, true, true>(lds + RING_OFF, g, S, E); } \
            bf16x8 qone = {0, 0, 0, 0, 0, 0, 0, 0}; if ((tid & 32) == 0) { qone[0] = (short)0x3F80; qone[1] = (short)0x3F80; qone[2] = (short)0x3F80; } \
            for (int rep_ = 0; rep_ < 1 + DUP_AS; ++rep_) for (int u = vcu; u < 256; u += G) fox::fox_sample_unit(u >> 3, u & 7, ((const int*)(ws + WS_JLO + 2048))[u], inp[2] + (size_t)l * 32 * PAST * 1024, inp[3] + (size_t)l * 32 * PAST * 1024, Kb, Vb, Qb, KBS, SZA, YN, (char*)lds_raw, qone); \
            fox::prompt_attn(vcu, G, Qb, Kb, Vb, KBP, SZA, YN, (const int*)(ws + WS_JLO), (char*)lds_raw, qone); \
            if (DUP_AP) { int v2_ = vcu; asm volatile("" : "+s"(v2_)); fox::prompt_attn(v2_, G, Qb, Kb, Vb, KBP, SZA, YN, (const int*)(ws + WS_JLO), (char*)lds_raw, qone); } \
        } \
        SEAM(ph + 4); \
          \
        if (IN(ph + 6)) { PHASE_PTRS; for (int rep_ = 0; rep_ < 1 + DUP_NORM; ++rep_) for (int m = gw; m < MROWS; m += NGW) norm_row_item(YN + (size_t)m * 2048, lane); } \
        SEAM(ph + 6); \
          \
        if (IN(ph + 7)) { PHASE_PTRS; \
            pg8::Gemm g{YN, (const bf16*)(ws + WS_WOUT) + (size_t)l * 2048 * 2048, MROWS, 2048, 2048}; pg8::StaticOrder S; S.init(MROWS, 2048, G, (int)blockIdx.x); \
            pg8::EpiOut E{l == 0 ? inp[0] : (const float*)out, l == 0 ? inp[1] : (const float*)(out + O_YS), out, ws, l}; \
            if (DUP_OUT) { pg8::EpiNull EN; pg8::Gemm gn = g; pg8::StaticOrder Sn = S; if (DUP_INO) { gn.A = XB; gn.Bt = (const bf16*)(ws + WS_WIN) + (size_t)l * N_IN * 2048; gn.N = N_IN; Sn.init(MROWS, N_IN, G, (int)blockIdx.x); } \
                pg8::gemm_phase<pg8::EpiNull, pg8::StaticOrder, true, true>(lds + RING_OFF, gn, Sn, EN); } \
            pg8::gemm_phase<pg8::EpiOut, pg8::StaticOrder, true, true>(lds + RING_OFF, g, S, E); \
        } \
        SEAM(ph + 7); \
        if (DUP_BAR && IN(ph + 7) && multi) { for (int xb_ = 0; xb_ < 8; ++xb_) xcd_barrier(bar); } \


constexpr int PH_PER_LAYER = 8, N_PHASES = 1 + DEPTH * PH_PER_LAYER;

struct Args { const float* in[25]; float* out; unsigned char* ws; int ph_lo, ph_hi; };
__global__ void __launch_bounds__(NWAVES * 64, 2) fwd_kernel(Args args) {
    extern __shared__ __attribute__((aligned(16))) unsigned char lds_raw[];
    LAS unsigned char* lds = (LAS unsigned char*)lds_raw;
    const int tid0 = threadIdx.x;
    const int G = gridDim.x; const int bx = blockIdx.x; const int vcu = (G % 8 == 0) ? (bx % 8) * (G / 8) + bx / 8 : bx;
    unsigned* ctl = (unsigned*)(args.ws + WS_CTL);
    volatile LAS unsigned* MISC = (volatile LAS unsigned*)(lds + MISC_OFF);
    if (tid0 < 32) MISC[tid0] = 0u;
    __syncthreads();
    const int lo = args.ph_lo, hi = args.ph_hi;
    const bool multi = (hi - lo) > 1;
    XcdBarrier bar; bar.bar = ctl + CW_BAR; bar.x = 0; bar.st = nullptr;
    if (multi) bar = xcd_barrier_post(ctl + CW_BAR, MISC + 8);
#define IN(k) (lo <= (k) && (k) < hi)
#define SEAM(k) do { if (IN(k) && IN((k) + 1)) xcd_barrier(bar); } while (0)
#define PHASE_PTRS int z_ = 0; int tid = tid0; asm volatile("" : "+s"(z_), "+v"(tid)); const int lane = tid & 63, wave = __builtin_amdgcn_readfirstlane(tid >> 6), gw = vcu * NWAVES + wave, NGW = G * NWAVES; (void)lane; (void)gw; (void)NGW; const float* const* inp = args.in + z_; unsigned char* ws = args.ws + z_; float* out = args.out + z_; float* rowsq = (float*)(ws + WS_CTL) + CW_ROWSQ; (void)inp; (void)out; (void)rowsq
#define XB ((bf16*)(ws + WS_XB))
#define Ub ((bf16*)(ws + WS_U))
#define SZS ((bf16*)(ws + WS_SZS))
#define Qb ((bf16*)(ws + WS_Q))
#define Kb ((bf16*)(ws + WS_K))
#define Vb ((bf16*)(ws + WS_V))
#define SZA ((bf16*)(ws + WS_SZA))
#define ZS ((bf16*)(ws + WS_ZS))
#define YN ((bf16*)(ws + WS_YN))
#define E16 ((float*)(ws + WS_E16))
#define HS ((bf16*)(ws + WS_HS))
#define LOGF ((float*)(ws + WS_LOGF))
#define KBP ((bf16*)(ws + WS_KBP))
#define KBS ((bf16*)(ws + WS_KBS))

    if (IN(0)) { PHASE_PTRS; p0_prologue(inp, ws, lds, tid, wave, lane, vcu, G); if (DUP_P0) { __syncthreads(); int v2_ = vcu; asm volatile("" : "+s"(v2_)); p0_prologue(inp, ws, lds, tid, wave, lane, v2_, G); } }
    SEAM(0);

    for (int l = 0; l < N_LAYERS_RUN; ++l) {
        const int ph = 1 + l * PH_PER_LAYER;
        if (IN(ph + 0)) { PHASE_PTRS;
            pg8::Gemm g{XB, (const bf16*)(ws + WS_WIN) + (size_t)l * N_IN * 2048, MROWS, N_IN, 2048}; pg8::StaticOrder S; S.init(MROWS, N_IN, G, (int)blockIdx.x);
            pg8::EpiIn E{ws, out, inp[10] + l * 128, inp[11] + l * 128, l, (LAS float*)(lds + RED_OFF)};
            if (DUP_INN) { pg8::EpiNull EN; pg8::gemm_phase<pg8::EpiNull, pg8::StaticOrder, true, true>(lds + RING_OFF, g, S, EN); }
            for (int rep_ = 0; rep_ < 1 + DUP_IN; ++rep_) pg8::gemm_phase<pg8::EpiIn, pg8::StaticOrder, true, true>(lds + RING_OFF, g, S, E);
            { const int nun = (MROWS / 256) * (N_IN / 256), rem = nun % G, first = rem, nlight = G - rem; const int c = (int)blockIdx.x;
              if (c >= first) { fpre_stage_wf((const bf16*)(ws + WS_WF) + (size_t)l * 16 * 2048, lds + RING_OFF, tid);
                for (int it = (c - first) * NWAVES + wave; it < MROWS / 16; it += nlight * NWAVES)
                  fpre_item(it, XB, lds + RING_OFF, rowsq + (size_t)l * MROWS, inp[9] + l * 8, LOGF, out + O_LFP + (size_t)l * MP * 8, out + O_LFS + (size_t)l * MS * 8, lane); } }
        }
        SEAM(ph + 0);
        if (IN(ph + 1)) { PHASE_PTRS;
            const bf16* WTl = (const bf16*)(ws + WS_WT) + (size_t)l * 64 * 128 * 256;
            for (int rep_ = 0; rep_ < 1 + DUP_S5A; ++rep_)
            for (int it = vcu; it < 256; it += G) e16_block_item(it, Ub, WTl, E16, lds + RING_OFF, tid, wave, lane);
        }
        SEAM(ph + 1);
        if (IN(ph + 2)) { PHASE_PTRS;
            const float* A16l = (const float*)(ws + WS_A16) + (size_t)l * 64 * 64 * 2;
            for (int rep_ = 0; rep_ < 1 + DUP_S5B; ++rep_) {
            for (int it = vcu; it < 128 + 16; it += G) {
                if (it < 128) carry_prompt_item(it, E16, A16l, HS, out + O_HRP + (size_t)l * 2 * 64 * 64, out + O_HIP + (size_t)l * 2 * 64 * 64, (LAS float*)(lds + RING_OFF), wave, lane);
                else cumsum_prompt_item(it - 128, LOGF, KBP, (int*)(ws + WS_JLO), 2.0f * ((const float*)(ws + WS_UB))[l] + ACP_T, (LAS float*)(lds + RING_OFF), tid, wave, lane);
            }
            for (int it = gw; it < 2048 + 256; it += NGW) {
                if (it < 2048) carry_sample_item(it, E16, A16l, inp[5] + (size_t)l * 32 * 64 * 64, inp[6] + (size_t)l * 32 * 64 * 64, HS, out + O_HRS + (size_t)l * 32 * 64 * 64, out + O_HIS + (size_t)l * 32 * 64 * 64, lane);
                else cumsum_sample_item(it - 2048, inp[4] + (size_t)l * 32 * PAST * 8, LOGF, KBS, (int*)(ws + WS_JLO + 2048), 2.0f * ((const float*)(ws + WS_UB))[l] + ACP_T, lane);
            } }
        }
        SEAM(ph + 2);
        STAGE_B_PHASES
    }
#undef IN
#undef SEAM
}

extern "C" void kernel_launch(void* const* d_in, const int* in_sizes, int n_in, void* d_out, int out_size, void* d_ws, size_t ws_size, hipStream_t stream) {
    static int grid = 0;
    if (grid == 0) {
        if (n_in != 25 || (size_t)out_size != O_END || ws_size < WS_END) { fprintf(stderr, "kernel_launch: unexpected shapes (n_in %d out %d ws %zu, need ws %zu)\n", n_in, out_size, ws_size, (size_t)WS_END); grid = -1; return; }
        int dev = 0, cus = 0, per_cu = 0;
        if (hipGetDevice(&dev) != hipSuccess || hipDeviceGetAttribute(&cus, hipDeviceAttributeMultiprocessorCount, dev) != hipSuccess) { grid = -1; return; }
        if (hipFuncSetAttribute((const void*)fwd_kernel, hipFuncAttributeMaxDynamicSharedMemorySize, LDS_BYTES) != hipSuccess) { fprintf(stderr, "kernel_launch: hipFuncSetAttribute failed\n"); grid = -1; return; }
        if (hipOccupancyMaxActiveBlocksPerMultiprocessor(&per_cu, (const void*)fwd_kernel, NWAVES * 64, LDS_BYTES) != hipSuccess || per_cu < 1) { fprintf(stderr, "kernel_launch: occupancy query says %d\n", per_cu); }
        (void)hipGetLastError();
        grid = cus;
    }
    if (grid < 0) return;
    if (hipMemsetAsync((char*)d_ws + WS_CTL, 0, CTL_ZERO_BYTES, stream) != hipSuccess) return;
#if STAGE_ZERO_OUT
    (void)hipMemsetAsync(d_out, 0, (size_t)out_size * 4, stream);
#endif
    Args a{};
    for (int i = 0; i < 25; ++i) a.in[i] = (const float*)d_in[i];
    a.out = (float*)d_out; a.ws = (unsigned char*)d_ws;
#if ONE_LAUNCH
    a.ph_lo = 0; a.ph_hi = N_PHASES;
    hipLaunchKernelGGL(fwd_kernel, dim3(grid), dim3(NWAVES * 64), LDS_BYTES, stream, a);
#else
    for (int p = 0; p < N_PHASES; ++p) { a.ph_lo = p; a.ph_hi = p + 1; hipLaunchKernelGGL(fwd_kernel, dim3(grid), dim3(NWAVES * 64), LDS_BYTES, stream, a); }
#endif
}
```
